# Optimizing an MI355X kernel written in HIP

```python
import jax
import jax.numpy as jnp
from jax import lax
import numpy as np

D_MODEL = 1024
BATCH = 2
SEQ = 16384
DEPTH = 2

HEAD_DIM = 64
ROPE_THETA = 500000.0
ROT_DIMS = HEAD_DIM // 4
NORM_EPS = 1e-6
D_FF = 2816
Q_BLOCK = 128
MASK_BIG = 1e30

NSA_HEADS = 8
NSA_KV_GROUPS = 2
NSA_HPG = NSA_HEADS // NSA_KV_GROUPS
CMP_LEN = 32
CMP_STRIDE = 16
CMP_HIDDEN = 2 * HEAD_DIM
SEL_LEN = 64
SEL_TOPN = 16
SEL_LOCAL = 2
WIN_LEN = 512

DIL_HEADS = 8
DIL_PAIRS = ((128, 1), (512, 4), (2048, 16))

MLA_HEADS = 16
MLA_Q_RANK = 256
MLA_KV_RANK = 128
MLA_NOPE = 64
MLA_ROPE = 32
MLA_V = 64

NSA_Q_W = NSA_HEADS * HEAD_DIM
NSA_KV_W = NSA_KV_GROUPS * HEAD_DIM
NSA_GATE_W = 3 * NSA_HEADS
DIL_W = DIL_HEADS * HEAD_DIM
EVEN_IN_SPLITS = (NSA_Q_W,) + (NSA_KV_W,) * 6 + (NSA_GATE_W,) + (DIL_W,) * 3
EVEN_IN_W = sum(EVEN_IN_SPLITS)
EVEN_OUT_W = NSA_Q_W + DIL_W
MLA_IN_W = MLA_Q_RANK + MLA_KV_RANK + MLA_ROPE
N_EVEN = (DEPTH + 1) // 2
N_ODD = DEPTH // 2

kernel_name = 'hybrid_nsa_dilated_mla_macaron'


def _rms_norm(x, g):
    xf = x.astype(jnp.float32)
    y = xf * lax.rsqrt(jnp.mean(xf * xf, axis=-1, keepdims=True) + NORM_EPS)
    return (y * g.astype(jnp.float32)).astype(x.dtype)


def _split(t, widths):
    cuts = [int(c) for c in np.cumsum(widths)[:-1]]
    return jnp.split(t, cuts, axis=-1)


def _rope_table(seq, dims):
    inv = ROPE_THETA ** (-jnp.arange(0, dims, 2, dtype=jnp.float32) / dims)
    ang = jnp.arange(seq, dtype=jnp.float32)[:, None] * inv[None, :]
    return jnp.cos(ang), jnp.sin(ang)


def _rope(x, cos, sin):
    half = x.shape[-1] // 2
    c = cos[:, None, :].astype(x.dtype)
    s = sin[:, None, :].astype(x.dtype)
    x1, x2 = x[..., :half], x[..., half:]
    return jnp.concatenate([x1 * c - x2 * s, x2 * c + x1 * s], axis=-1)


def _partial_rope(x, cos, sin):
    return jnp.concatenate([_rope(x[..., :ROT_DIMS], cos, sin), x[..., ROT_DIMS:]], axis=-1)


def _swiglu(x, w_gate, w_up, w_down):
    return (jax.nn.silu(x @ w_gate) * (x @ w_up)) @ w_down


def _probs(scores, mask):
    s = jnp.where(mask, scores.astype(jnp.float32), -MASK_BIG)
    m = jnp.max(s, axis=-1, keepdims=True)
    p = jnp.where(mask, jnp.exp(s - m), 0.0)
    l = jnp.sum(p, axis=-1, keepdims=True)
    l_safe = jnp.where(l > 0, l, 1.0)
    return p / l_safe, (m + jnp.log(l_safe))[..., 0]


def _banded_attention(q, k, v, span):
    n, L, h, d = q.shape
    blk = span
    nb = -(-L // blk)
    pad = nb * blk - L
    to_blocks = lambda t: jnp.pad(t, ((0, 0), (0, pad), (0, 0), (0, 0))).reshape(n, nb, blk, h, d)
    qb, kb, vb = to_blocks(q), to_blocks(k), to_blocks(v)
    with_prev = lambda t: jnp.concatenate([jnp.concatenate([jnp.zeros_like(t[:, :1]), t[:, :-1]], axis=1), t], axis=2)
    kk, vv = with_prev(kb), with_prev(vb)
    sc = jnp.einsum('nbqhd,nbkhd->nbhqk', qb, kk) * (d ** -0.5)
    qi = jnp.arange(blk)[:, None] + blk
    ki = jnp.arange(2 * blk)[None, :]
    dist = qi - ki
    band = (dist >= 0) & (dist <= span)
    has_prev = (jnp.arange(nb) > 0)[:, None, None] | (ki >= blk)[None]
    mask = band[None] & has_prev
    p, lse = _probs(sc, mask[None, :, None])
    o = jnp.einsum('nbhqk,nbkhd->nbqhd', p.astype(v.dtype), vv).reshape(n, nb * blk, h, d)[:, :L]
    lse = lse.transpose(0, 1, 3, 2).reshape(n, nb * blk, h)[:, :L]
    return o, lse


def _dilated_branch(q, k, v, window, dil):
    b, s, h, d = q.shape
    L = s // dil
    to_res = lambda t: t.reshape(b, L, dil, h, d).transpose(0, 2, 1, 3, 4).reshape(b * dil, L, h, d)
    o, lse = _banded_attention(to_res(q), to_res(k), to_res(v), window // dil)
    o = o.reshape(b, dil, L, h, d).transpose(0, 2, 1, 3, 4).reshape(b, s, h, d)
    lse = lse.reshape(b, dil, L, h).transpose(0, 2, 1, 3).reshape(b, s, h)
    return o, lse


def _dilated_mixture(q, k, v):
    b, s, h, d = q.shape
    outs, lses = [], []
    for window, dil in DIL_PAIRS:
        o, lse = _dilated_branch(q, k, v, window, dil)
        outs.append(o)
        lses.append(lse)
    w = jax.nn.softmax(jnp.stack(lses, axis=0), axis=0)
    o = jnp.sum(w[..., None] * jnp.stack(outs, axis=0), axis=0)
    return o.astype(q.dtype).reshape(b, s, h * d)


def _compress(t, pos_emb, w1, w2):
    b, s, g, d = t.shape
    r = CMP_LEN // CMP_STRIDE
    n_chunks = s // CMP_STRIDE
    n_cmp = n_chunks - r + 1
    ch = t.reshape(b, n_chunks, CMP_STRIDE, g, d)
    blocks = jnp.concatenate([ch[:, i:i + n_cmp] for i in range(r)], axis=2)
    blocks = blocks + pos_emb[None, None, :, None, :]
    flat = blocks.transpose(0, 1, 3, 2, 4).reshape(b, n_cmp, g, CMP_LEN * d)
    return jax.nn.silu(flat @ w1) @ w2


def _cmp_to_sel_matrix(n_cmp, n_sel):
    a = SEL_LEN // CMP_STRIDE
    c = CMP_LEN // CMP_STRIDE
    rel = jnp.arange(n_cmp)[:, None] - a * jnp.arange(n_sel)[None, :]
    return sum((rel == (m - n)).astype(jnp.float32) for m in range(a) for n in range(c))


def _nsa(q, kc_raw, vc_raw, ks, vs, kw, vw, gates, pos_k, pos_v, ck_w1, ck_w2, cv_w1, cv_w2):
    b, s, G, HPG, D = q.shape
    scale = D ** -0.5
    kc = _compress(kc_raw, pos_k, ck_w1, ck_w2)
    vc = _compress(vc_raw, pos_v, cv_w1, cv_w2)
    n_cmp = kc.shape[1]
    cmp_end = jnp.arange(n_cmp) * CMP_STRIDE + (CMP_LEN - 1)
    n_sel = s // SEL_LEN
    n_top = min(SEL_TOPN, n_sel)
    imp_map = _cmp_to_sel_matrix(n_cmp, n_sel)
    ks_blk = ks.reshape(b, n_sel, SEL_LEN, G, D).transpose(0, 3, 1, 2, 4)
    vs_blk = vs.reshape(b, n_sel, SEL_LEN, G, D).transpose(0, 3, 1, 2, 4)
    kw_pad = jnp.pad(kw, ((0, 0), (WIN_LEN, 0), (0, 0), (0, 0)))
    vw_pad = jnp.pad(vw, ((0, 0), (WIN_LEN, 0), (0, 0), (0, 0)))
    gather_blocks = jax.vmap(jax.vmap(lambda blk, ix: blk[ix]))
    sel_off = jnp.arange(SEL_LEN)
    blk_ids = jnp.arange(n_sel)
    nq = s // Q_BLOCK

    def chunk(args):
        ci, qc, gc = args
        t = ci * Q_BLOCK + jnp.arange(Q_BLOCK)
        s_c = jnp.einsum('bqghd,bngd->bghqn', qc, kc) * scale
        p_c, _ = _probs(s_c, cmp_end[None, :] <= t[:, None])
        o_c = jnp.einsum('bghqn,bngd->bqghd', p_c.astype(qc.dtype), vc)
        imp = jnp.einsum('bghqn,nj->bgqj', p_c, imp_map)
        rel = (t // SEL_LEN)[:, None] - blk_ids[None, :]
        forced = (blk_ids[None, :] == 0) | ((rel >= 0) & (rel < SEL_LOCAL))
        imp = jnp.where(forced, MASK_BIG, jnp.where(rel >= 0, imp, -MASK_BIG))
        _, idx = lax.top_k(imp, n_top)
        k_sel = gather_blocks(ks_blk, idx).reshape(b, G, Q_BLOCK, n_top * SEL_LEN, D)
        v_sel = gather_blocks(vs_blk, idx).reshape(b, G, Q_BLOCK, n_top * SEL_LEN, D)
        key_pos = (idx[..., None] * SEL_LEN + sel_off).reshape(b, G, Q_BLOCK, n_top * SEL_LEN)
        s_s = jnp.einsum('bqghd,bgqkd->bghqk', qc, k_sel) * scale
        p_s, _ = _probs(s_s, (key_pos <= t[:, None])[:, :, None])
        o_s = jnp.einsum('bghqk,bgqkd->bqghd', p_s.astype(qc.dtype), v_sel)
        k_win = lax.dynamic_slice_in_dim(kw_pad, ci * Q_BLOCK, Q_BLOCK + WIN_LEN, axis=1)
        v_win = lax.dynamic_slice_in_dim(vw_pad, ci * Q_BLOCK, Q_BLOCK + WIN_LEN, axis=1)
        pos_w = ci * Q_BLOCK - WIN_LEN + jnp.arange(Q_BLOCK + WIN_LEN)
        dist = t[:, None] - pos_w[None, :]
        mask_w = (pos_w[None, :] >= 0) & (dist >= 0) & (dist < WIN_LEN)
        s_w = jnp.einsum('bqghd,bkgd->bghqk', qc, k_win) * scale
        p_w, _ = _probs(s_w, mask_w)
        o_w = jnp.einsum('bghqk,bkgd->bqghd', p_w.astype(qc.dtype), v_win)
        return gc[..., 0:1] * o_c + gc[..., 1:2] * o_s + gc[..., 2:3] * o_w

    q_chunks = q.reshape(b, nq, Q_BLOCK, G, HPG, D).swapaxes(0, 1)
    g_chunks = gates.reshape(b, nq, Q_BLOCK, G, HPG, 3).swapaxes(0, 1)
    out = lax.map(chunk, (jnp.arange(nq), q_chunks, g_chunks))
    return out.swapaxes(0, 1).reshape(b, s, G * HPG * D)


def _even_mixer(h, w_in, w_out, pos_k, pos_v, ck_w1, ck_w2, cv_w1, cv_w2, cos_p, sin_p):
    b, s, _ = h.shape
    q_a, kc, vc, ks, vs, kw, vw, gates, q_b, k_b, v_b = _split(h @ w_in, EVEN_IN_SPLITS)
    heads = lambda t: t.reshape(b, s, -1, HEAD_DIM)
    q_a = _partial_rope(heads(q_a), cos_p, sin_p).reshape(b, s, NSA_KV_GROUPS, NSA_HPG, HEAD_DIM)
    kc, ks, kw = [_partial_rope(heads(t), cos_p, sin_p) for t in (kc, ks, kw)]
    gates = jax.nn.sigmoid(gates).reshape(b, s, NSA_KV_GROUPS, NSA_HPG, 3)
    o_a = _nsa(q_a, kc, heads(vc), ks, heads(vs), kw, heads(vw), gates,
               pos_k, pos_v, ck_w1, ck_w2, cv_w1, cv_w2)
    o_b = _dilated_mixture(_partial_rope(heads(q_b), cos_p, sin_p),
                           _partial_rope(heads(k_b), cos_p, sin_p), heads(v_b))
    return jnp.concatenate([o_a, o_b], axis=-1) @ w_out


def _mla_mixer(h, w_in, q_norm, kv_norm, w_uq, w_ukv, w_out, cos_m, sin_m):
    b, s, _ = h.shape
    H = MLA_HEADS
    cq, ckv, k_rope = _split(h @ w_in, (MLA_Q_RANK, MLA_KV_RANK, MLA_ROPE))
    q = (_rms_norm(cq, q_norm) @ w_uq).reshape(b, s, H, MLA_NOPE + MLA_ROPE)
    q_nope, q_rope = q[..., :MLA_NOPE], _rope(q[..., MLA_NOPE:], cos_m, sin_m)
    k_rope = _rope(k_rope[:, :, None, :], cos_m, sin_m)[:, :, 0]
    kv = (_rms_norm(ckv, kv_norm) @ w_ukv).reshape(b, s, H, MLA_NOPE + MLA_V)
    k_nope, v = kv[..., :MLA_NOPE], kv[..., MLA_NOPE:]
    scale = (MLA_NOPE + MLA_ROPE) ** -0.5
    nq = s // Q_BLOCK
    k_pos = jnp.arange(s)

    def chunk(args):
        ci, qn, qr = args
        t = ci * Q_BLOCK + jnp.arange(Q_BLOCK)
        sc = (jnp.einsum('bqhd,bkhd->bhqk', qn, k_nope) + jnp.einsum('bqhr,bkr->bhqk', qr, k_rope)) * scale
        p, _ = _probs(sc, k_pos[None, :] <= t[:, None])
        return jnp.einsum('bhqk,bkhd->bqhd', p.astype(v.dtype), v)

    qn_c = q_nope.reshape(b, nq, Q_BLOCK, H, MLA_NOPE).swapaxes(0, 1)
    qr_c = q_rope.reshape(b, nq, Q_BLOCK, H, MLA_ROPE).swapaxes(0, 1)
    out = lax.map(chunk, (jnp.arange(nq), qn_c, qr_c))
    return out.swapaxes(0, 1).reshape(b, s, H * MLA_V) @ w_out


def setup_inputs(seed: int = 0) -> dict:
    key = jax.random.key(seed)
    specs = [
        ('x', (BATCH, SEQ, D_MODEL), 'w', 1.0),
        ('ffn1_norm', (DEPTH, D_MODEL), 'g', 0.0),
        ('ffn1_w_gate', (DEPTH, D_MODEL, D_FF), 'w', D_MODEL ** -0.5),
        ('ffn1_w_up', (DEPTH, D_MODEL, D_FF), 'w', D_MODEL ** -0.5),
        ('ffn1_w_down', (DEPTH, D_FF, D_MODEL), 'w', D_FF ** -0.5),
        ('ffn2_norm', (DEPTH, D_MODEL), 'g', 0.0),
        ('ffn2_w_gate', (DEPTH, D_MODEL, D_FF), 'w', D_MODEL ** -0.5),
        ('ffn2_w_up', (DEPTH, D_MODEL, D_FF), 'w', D_MODEL ** -0.5),
        ('ffn2_w_down', (DEPTH, D_FF, D_MODEL), 'w', D_FF ** -0.5),
        ('mix_norm', (DEPTH, D_MODEL), 'g', 0.0),
        ('ev_w_in', (N_EVEN, D_MODEL, EVEN_IN_W), 'w', D_MODEL ** -0.5),
        ('ev_w_out', (N_EVEN, EVEN_OUT_W, D_MODEL), 'w', EVEN_OUT_W ** -0.5),
        ('nsa_cmp_pos_k', (N_EVEN, CMP_LEN, HEAD_DIM), 'w', 0.1),
        ('nsa_cmp_pos_v', (N_EVEN, CMP_LEN, HEAD_DIM), 'w', 0.1),
        ('nsa_cmp_k_w1', (N_EVEN, CMP_LEN * HEAD_DIM, CMP_HIDDEN), 'w', (CMP_LEN * HEAD_DIM) ** -0.5),
        ('nsa_cmp_k_w2', (N_EVEN, CMP_HIDDEN, HEAD_DIM), 'w', CMP_HIDDEN ** -0.5),
        ('nsa_cmp_v_w1', (N_EVEN, CMP_LEN * HEAD_DIM, CMP_HIDDEN), 'w', (CMP_LEN * HEAD_DIM) ** -0.5),
        ('nsa_cmp_v_w2', (N_EVEN, CMP_HIDDEN, HEAD_DIM), 'w', CMP_HIDDEN ** -0.5),
        ('mla_w_in', (N_ODD, D_MODEL, MLA_IN_W), 'w', D_MODEL ** -0.5),
        ('mla_q_norm', (N_ODD, MLA_Q_RANK), 'g', 0.0),
        ('mla_kv_norm', (N_ODD, MLA_KV_RANK), 'g', 0.0),
        ('mla_w_uq', (N_ODD, MLA_Q_RANK, MLA_HEADS * (MLA_NOPE + MLA_ROPE)), 'w', MLA_Q_RANK ** -0.5),
        ('mla_w_ukv', (N_ODD, MLA_KV_RANK, MLA_HEADS * (MLA_NOPE + MLA_V)), 'w', MLA_KV_RANK ** -0.5),
        ('mla_w_out', (N_ODD, MLA_HEADS * MLA_V, D_MODEL), 'w', (MLA_HEADS * MLA_V) ** -0.5),
        ('final_norm', (D_MODEL,), 'g', 0.0),
    ]
    keys = jax.random.split(key, len(specs))
    out = {}
    for k, (name, shape, kind, sc) in zip(keys, specs):
        z = jax.random.normal(k, shape, dtype=jnp.float32)
        out[name] = 1.0 + 0.02 * z if kind == 'g' else z * sc
    return out


def reference(x, ffn1_norm, ffn1_w_gate, ffn1_w_up, ffn1_w_down,
              ffn2_norm, ffn2_w_gate, ffn2_w_up, ffn2_w_down, mix_norm,
              ev_w_in, ev_w_out, nsa_cmp_pos_k, nsa_cmp_pos_v,
              nsa_cmp_k_w1, nsa_cmp_k_w2, nsa_cmp_v_w1, nsa_cmp_v_w2,
              mla_w_in, mla_q_norm, mla_kv_norm, mla_w_uq, mla_w_ukv, mla_w_out,
              final_norm):
    s = x.shape[1]
    cos_p, sin_p = _rope_table(s, ROT_DIMS)
    cos_m, sin_m = _rope_table(s, MLA_ROPE)
    for l in range(DEPTH):
        x = x + 0.5 * _swiglu(_rms_norm(x, ffn1_norm[l]), ffn1_w_gate[l], ffn1_w_up[l], ffn1_w_down[l])
        h = _rms_norm(x, mix_norm[l])
        if l % 2 == 0:
            e = l // 2
            x = x + _even_mixer(h, ev_w_in[e], ev_w_out[e], nsa_cmp_pos_k[e], nsa_cmp_pos_v[e],
                                nsa_cmp_k_w1[e], nsa_cmp_k_w2[e], nsa_cmp_v_w1[e], nsa_cmp_v_w2[e],
                                cos_p, sin_p)
        else:
            o = l // 2
            x = x + _mla_mixer(h, mla_w_in[o], mla_q_norm[o], mla_kv_norm[o], mla_w_uq[o],
                               mla_w_ukv[o], mla_w_out[o], cos_m, sin_m)
        x = x + 0.5 * _swiglu(_rms_norm(x, ffn2_norm[l]), ffn2_w_gate[l], ffn2_w_up[l], ffn2_w_down[l])
    return _rms_norm(x, final_norm)
```

```cpp
#include <hip/hip_runtime.h>
#include <hip/hip_cooperative_groups.h>
#include <cstdio>
#include <cstdint>
namespace cg = cooperative_groups;

#define DI __device__ __forceinline__
#define LAS __attribute__((address_space(3)))
#define GAS __attribute__((address_space(1)))
#define OTID() ({ int t_ = threadIdx.x; asm volatile("" : "+v"(t_)); t_; })
typedef unsigned short bf16_t;
typedef short bf16x8 __attribute__((ext_vector_type(8)));
typedef short s16x4 __attribute__((ext_vector_type(4)));
typedef float f32x4 __attribute__((ext_vector_type(4)));
typedef float f32x2 __attribute__((ext_vector_type(2)));
typedef float f32x16 __attribute__((ext_vector_type(16)));
typedef unsigned u32x4 __attribute__((ext_vector_type(4)));
typedef unsigned u32x2 __attribute__((ext_vector_type(2)));
typedef __bf16 bf16x2_t __attribute__((ext_vector_type(2)));

DI unsigned cvtpk(float lo, float hi) { f32x2 v = {lo, hi}; bf16x2_t b = __builtin_convertvector(v, bf16x2_t); return __builtin_bit_cast(unsigned, b); }
DI float bf2f(unsigned short u) { return __uint_as_float(((unsigned)u) << 16); }
DI float bflo(unsigned u) { return __uint_as_float(u << 16); }
DI float bfhi(unsigned u) { return __uint_as_float(u & 0xffff0000u); }
DI float fexp2(float x) { return __builtin_amdgcn_exp2f(x); }
DI float frcp(float x) { return __builtin_amdgcn_rcpf(x); }
DI float silu_f(float x) { return x * frcp(1.0f + fexp2(-1.4426950408889634f * x)); }
DI float sigmoid_f(float x) { return frcp(1.0f + fexp2(-1.4426950408889634f * x)); }

constexpr int SEQ = 16384, NB = 2, M = NB * SEQ, DM = 1024, DFF = 2816;
constexpr float EPS = 1e-6f;
constexpr float LOG2E = 1.4426950408889634f, LN2 = 0.6931471805599453f;
constexpr int PROJ_W = 3072;
#define PSLOT(P, col) ((P) + (size_t)((col) >> 6) * M * 64)
constexpr int C_QA = 0, C_KC = 512, C_VC = 640, C_KS = 768, C_VS = 896, C_KW = 1024, C_VW = 1152, C_QB = 1280, C_KB = 1792, C_VB = 2304, C_GT = 2816;

constexpr size_t MiB = 1u << 20;
constexpr size_t SZ_WGU = (size_t)5632 * 1024 * 2, SZ_WD = (size_t)1024 * 2816 * 2;
constexpr size_t WS_WGU = 1 * MiB;
constexpr size_t WS_WD = WS_WGU + 4 * SZ_WGU;
constexpr size_t WS_WEI = WS_WD + 4 * SZ_WD;
constexpr size_t WS_WEO = WS_WEI + (size_t)3072 * 1024 * 2;
constexpr size_t WS_WC1 = WS_WEO + (size_t)1024 * 1024 * 2;
constexpr size_t WS_WMI = WS_WC1 + (size_t)256 * 2048 * 2;
constexpr size_t WS_WUQ = WS_WMI + (size_t)512 * 1024 * 2;
constexpr size_t WS_WUKV = WS_WUQ + (size_t)1536 * 256 * 2;
constexpr size_t WS_WMO = WS_WUKV + (size_t)2048 * 128 * 2;
constexpr size_t WS_CSP = WS_WMO + (size_t)1024 * 1024 * 2;
constexpr size_t WS_CSM = WS_CSP + (size_t)SEQ * 16 * 4;
constexpr size_t WS_RS = WS_CSM + (size_t)SEQ * 32 * 4;
constexpr size_t WS_XB = ((WS_RS + (size_t)9 * M * 4 + MiB - 1) / MiB) * MiB;
constexpr size_t WS_AO = WS_XB + (size_t)M * 1024 * 2;
constexpr size_t WS_BIG = WS_AO + (size_t)M * 1024 * 2;
constexpr size_t WS_MID = WS_BIG + 224 * MiB;
constexpr size_t WS_END = WS_MID + 72 * MiB;
constexpr size_t MID_OC = 0, MID_OW = 32 * MiB, MID_LSE = 64 * MiB, MID_SELM = 66 * MiB, MID_HID = 68 * MiB, MID_KC = 70 * MiB, MID_VC = 70 * MiB + 512 * 1024;

namespace pg8 {
constexpr int BM = 256, BK = 64, HALF = 128, HTB = HALF * BK * 2, STAGE_BYTES = 8 * HTB, NXCD = 8, WGM = 8;
DI int lds_byte(int r, int c) { const int st = (r >> 4) * 2 + (c >> 5), rr = r & 15, cc = c & 31, ob = rr * 64 + cc * 2; return st * 1024 + (ob ^ (((ob >> 9) & 1) << 5)); }
DI void stage_rc(int b, int& R, int& C) { const int st = b / 1024, sb = b % 1024, swz = sb ^ (((sb >> 9) & 1) << 5); R = (st >> 1) * 16 + swz / 64; C = (st & 1) * 32 + (swz % 64) / 2; }
DI int perm32(int rho) { const int n = rho >> 4, i = rho & 15; return 8 * (i >> 2) + 4 * n + (i & 3); }
struct Unit { int pm, pn; };
struct Gemm { const bf16_t* A; const bf16_t* Bt; int M, N, K, lda; };
struct StaticOrder {
    int nM, nN, nwg, G, c;
    DI void init(int M_, int N_, int G_, int c_) { nM = M_ / BM; nN = N_ / BM; nwg = nM * nN; G = G_; c = c_; }
    DI bool next(int i, Unit& u) const {
        const long L = (long)i * G + c; if (L >= nwg) return false;
        int wgid = (int)L; { const int q = nwg / NXCD, r = nwg % NXCD, xcd = wgid % NXCD, off = wgid / NXCD; wgid = (xcd < r ? xcd * (q + 1) : r * (q + 1) + (xcd - r) * q) + off; }
        const int nig = WGM * nN, gid = wgid / nig, fm = gid * WGM, gsz = (nM - fm) < WGM ? (nM - fm) : WGM;
        u.pm = fm + ((wgid % nig) % gsz); u.pn = (wgid % nig) / gsz; return true;
    }
};
template <class Epi, bool ALIGN_EPI>
DI void gemm_phase(LAS unsigned char* lds, const Gemm g, const StaticOrder& S, const Epi& E) {
    int tid_ = threadIdx.x; asm volatile("" : "+v"(tid_));
    const int tid = tid_, wid = __builtin_amdgcn_readfirstlane(tid >> 6), lane = tid & 63, wr = wid >> 2, wc = wid & 3, fr = lane & 15, fq = lane >> 4;
    int K_ = g.K, lda_ = g.lda; asm volatile("" : "+s"(K_), "+s"(lda_));
    const int K = K_, nt = K / BK, lda = lda_;
    unsigned voffA[2], voffB[2];
#pragma unroll
    for (int i = 0; i < 2; ++i) { int R, C; stage_rc(tid * 16 + i * 8192, R, C); const int Rb = Epi::PERM ? ((R & ~31) + perm32(R & 31)) : R;
        voffA[i] = (unsigned)(R * lda + C) * 2u; voffB[i] = (unsigned)(Rb * K + C) * 2u; }
    const size_t kstep = (size_t)(BK * 2);
    const size_t hstepA = (size_t)HALF * lda * 2, hstepB = (size_t)HALF * K * 2;
    const size_t tstepA = 2 * hstepA, tstepB = 2 * hstepB;
    const unsigned ldsw = (unsigned)wid * 1024u;
    const int aoff = lds_byte(wr * 64 + fr, fq * 8), boff = lds_byte(wc * 32 + fr, fq * 8);
#define PG8_SA(b, h) (((b) * 2 + (h)) * HTB)
#define PG8_SB(b, h) ((4 + (b) * 2 + (h)) * HTB)
#define PG8_STAGE(bufoff, gbase, voff) do { _Pragma("unroll") for (int _i = 0; _i < 2; ++_i) \
        __builtin_amdgcn_global_load_lds((const unsigned*)((const char*)(gbase) + (voff)[_i]), (LAS unsigned*)(lds + (bufoff) + ldsw + _i * 8192), 16, 0, 0); } while (0)
#define PG8_LDA(dst, b, h) do { _Pragma("unroll") for (int m = 0; m < 4; ++m) _Pragma("unroll") for (int k = 0; k < 2; ++k) dst[m][k] = *(const LAS bf16x8*)(lds + PG8_SA(b, h) + aoff + m * 2048 + k * 1024); } while (0)
#define PG8_LDB(dst, b, h) do { _Pragma("unroll") for (int n = 0; n < 2; ++n) _Pragma("unroll") for (int k = 0; k < 2; ++k) dst[n][k] = *(const LAS bf16x8*)(lds + PG8_SB(b, h) + boff + n * 2048 + k * 1024); } while (0)
#define PG8_MMA(ai, bj, At, Bt) do { __builtin_amdgcn_s_setprio(1); _Pragma("unroll") for (int m = 0; m < 4; ++m) _Pragma("unroll") for (int n = 0; n < 2; ++n) _Pragma("unroll") for (int k = 0; k < 2; ++k) \
        acc[ai][bj][m][n] = __builtin_amdgcn_mfma_f32_16x16x32_bf16(Bt[n][k], At[m][k], acc[ai][bj][m][n], 0, 0, 0); __builtin_amdgcn_s_setprio(0); } while (0)
#define PG8_WAIT_V(n) asm volatile("s_waitcnt vmcnt(" #n ")" ::: "memory")
#define PG8_WAIT_L(n) asm volatile("s_waitcnt lgkmcnt(" #n ")" ::: "memory")
#define PG8_BAR __builtin_amdgcn_s_barrier()
#define PG8_SCHED __builtin_amdgcn_sched_barrier(0)
    Unit cur, nxt; int ui = 0;
    if (!S.next(0, cur)) return;
    f32x4 acc[2][2][4][2];
#pragma unroll
    for (int a = 0; a < 2; ++a)
#pragma unroll
        for (int b = 0; b < 2; ++b)
#pragma unroll
            for (int m = 0; m < 4; ++m)
#pragma unroll
                for (int n = 0; n < 2; ++n) acc[a][b][m][n] = (f32x4){0.f, 0.f, 0.f, 0.f};
    bf16x8 At[4][2], B0[2][2], B1[2][2];
    const char* cA = (const char*)g.A + (size_t)cur.pm * tstepA; const char* cB = (const char*)g.Bt + (size_t)cur.pn * tstepB;
    PG8_STAGE(PG8_SB(0, 0), cB, voffB); PG8_STAGE(PG8_SB(0, 1), cB + hstepB, voffB); PG8_STAGE(PG8_SA(0, 0), cA, voffA); PG8_STAGE(PG8_SA(0, 1), cA + hstepA, voffA);
    if (wr == 1) PG8_BAR;
    PG8_WAIT_V(2); PG8_BAR;
    PG8_STAGE(PG8_SB(1, 0), cB + kstep, voffB); PG8_STAGE(PG8_SA(1, 0), cA + kstep, voffA); PG8_STAGE(PG8_SB(1, 1), cB + hstepB + kstep, voffB);
    PG8_WAIT_V(6); PG8_BAR;
    for (;;) {
        const bool has_next = S.next(ui + 1, nxt);
        const char* nA = has_next ? (const char*)g.A + (size_t)nxt.pm * tstepA : cA; const char* nB = has_next ? (const char*)g.Bt + (size_t)nxt.pn * tstepB : cB;
        for (int t = 0; t < nt; t += 2) {
            const bool last = (t == nt - 2);
            const char* a1 = cA + (size_t)(t + 1) * kstep;
            const char* a2 = last ? nA : cA + (size_t)(t + 2) * kstep; const char* b2 = last ? nB : cB + (size_t)(t + 2) * kstep;
            const char* a3 = a2 + kstep; const char* b3 = b2 + kstep;
            PG8_LDB(B0, 0, 0); PG8_LDB(B1, 0, 1); PG8_SCHED; PG8_LDA(At, 0, 0); PG8_STAGE(PG8_SA(1, 1), a1 + hstepA, voffA);
            PG8_WAIT_V(8); PG8_WAIT_L(0); PG8_BAR; PG8_MMA(0, 0, At, B0); PG8_MMA(0, 1, At, B1); PG8_BAR; PG8_SCHED;
            PG8_LDA(At, 0, 1); PG8_STAGE(PG8_SB(0, 0), b2, voffB); PG8_STAGE(PG8_SB(0, 1), b2 + hstepB, voffB); PG8_STAGE(PG8_SA(0, 0), a2, voffA);
            PG8_WAIT_V(8); PG8_WAIT_L(0); PG8_BAR; PG8_MMA(1, 0, At, B0); PG8_MMA(1, 1, At, B1); PG8_BAR; PG8_SCHED;
            PG8_LDB(B0, 1, 0); PG8_LDB(B1, 1, 1); PG8_SCHED; PG8_LDA(At, 1, 0); PG8_STAGE(PG8_SA(0, 1), a2 + hstepA, voffA);
            PG8_WAIT_V(8); PG8_WAIT_L(0); PG8_BAR; PG8_MMA(0, 0, At, B0); PG8_MMA(0, 1, At, B1); PG8_BAR; PG8_SCHED;
            PG8_LDA(At, 1, 1); PG8_STAGE(PG8_SB(1, 0), b3, voffB); PG8_STAGE(PG8_SB(1, 1), b3 + hstepB, voffB); PG8_STAGE(PG8_SA(1, 0), a3, voffA);
            PG8_WAIT_V(8); PG8_WAIT_L(0); PG8_BAR; PG8_MMA(1, 0, At, B0); PG8_MMA(1, 1, At, B1); PG8_BAR; PG8_SCHED;
        }
        if constexpr (ALIGN_EPI) { if (wr == 0) PG8_BAR; }
        E(acc, cur, wr, wc, fr, fq);
        if (!has_next) break;
#pragma unroll
        for (int a = 0; a < 2; ++a)
#pragma unroll
            for (int b = 0; b < 2; ++b)
#pragma unroll
                for (int m = 0; m < 4; ++m)
#pragma unroll
                    for (int n = 0; n < 2; ++n) acc[a][b][m][n] = (f32x4){0.f, 0.f, 0.f, 0.f};
        cur = nxt; cA = nA; cB = nB; ++ui;
        if constexpr (ALIGN_EPI) { if (wr == 1) PG8_BAR; }
    }
    PG8_WAIT_V(0);
    if constexpr (!ALIGN_EPI) { if (wr == 0) PG8_BAR; }
    PG8_BAR;
#undef PG8_SA
#undef PG8_SB
#undef PG8_STAGE
#undef PG8_LDA
#undef PG8_LDB
#undef PG8_MMA
#undef PG8_WAIT_V
#undef PG8_WAIT_L
#undef PG8_BAR
#undef PG8_SCHED
}
}

typedef f32x4 AccT[2][2][4][2];
DI float row_rs(const float* rs, int row, float invn) { return __builtin_amdgcn_rsqf(rs[row] * invn + EPS); }

struct EpiSwiglu {
    static constexpr bool PERM = true;
    bf16_t* H; const float* rs;
    DI void operator()(const AccT& acc, const pg8::Unit& u, int wr, int wc, int fr, int fq) const {
        const int row0 = u.pm * 256 + wr * 64 + fr, col = u.pn * 128 + wc * 32 + 8 * fq;
        float rr[2][4];
#pragma unroll
        for (int ai = 0; ai < 2; ++ai)
#pragma unroll
            for (int m = 0; m < 4; ++m) rr[ai][m] = *(const GAS float*)(rs + row0 + ai * 128 + m * 16);
#pragma unroll
        for (int ai = 0; ai < 2; ++ai)
#pragma unroll
            for (int m = 0; m < 4; ++m) {
                const int row = row0 + ai * 128 + m * 16; const float r = __builtin_amdgcn_rsqf(rr[ai][m] * (1.0f / 1024.0f) + EPS);
                float hv[8];
#pragma unroll
                for (int n = 0; n < 2; ++n)
#pragma unroll
                    for (int e = 0; e < 4; ++e) { const float gv = acc[ai][0][m][n][e] * r, uv = acc[ai][1][m][n][e] * r; hv[n * 4 + e] = silu_f(gv) * uv; }
                u32x4 w; w.x = cvtpk(hv[0], hv[1]); w.y = cvtpk(hv[2], hv[3]); w.z = cvtpk(hv[4], hv[5]); w.w = cvtpk(hv[6], hv[7]);
                *(GAS u32x4*)(H + (size_t)row * DFF + col) = w;
            }
    }
};
struct EpiResid {
    static constexpr bool PERM = false;
    const float* base; float* out; bf16_t* xb; float* rs_out; float coef;
    DI void operator()(const AccT& acc, const pg8::Unit& u, int wr, int wc, int fr, int fq) const {
        const int row0 = u.pm * 256 + wr * 64 + fr, col0 = u.pn * 256 + wc * 32 + 4 * fq;
#pragma unroll
        for (int ai = 0; ai < 2; ++ai)
#pragma unroll
            for (int m = 0; m < 4; ++m) {
                const int row = row0 + ai * 128 + m * 16; const size_t off = (size_t)row * DM + col0; float ss = 0.f;
#pragma unroll
                for (int bj = 0; bj < 2; ++bj)
#pragma unroll
                    for (int n = 0; n < 2; ++n) {
                        const f32x4 bs = *(const f32x4*)(base + off + bj * 128 + n * 16);
                        const f32x4 v = bs + acc[ai][bj][m][n] * coef;
                        *(f32x4*)(out + off + bj * 128 + n * 16) = v;
                        if (xb) { u32x2 w; w.x = cvtpk(v[0], v[1]); w.y = cvtpk(v[2], v[3]); *(u32x2*)(xb + off + bj * 128 + n * 16) = w; }
                        ss += (v[0] * v[0] + v[1] * v[1]) + (v[2] * v[2] + v[3] * v[3]);
                    }
                ss += __shfl_xor(ss, 16); ss += __shfl_xor(ss, 32);
                if (fq == 0) atomicAdd(rs_out + row, ss);
            }
    }
};
struct EpiEvenIn {
    static constexpr bool PERM = true;
    bf16_t* P; const float* rs; const float* csp;
    DI void operator()(const AccT& acc, const pg8::Unit& u, int wr, int wc, int fr, int fq) const {
        const int row0 = u.pm * 256 + wr * 64 + fr;
#pragma unroll
        for (int bj = 0; bj < 2; ++bj) {
            const int cw = u.pn * 256 + bj * 128 + wc * 32;
            if (cw >= 2848) continue;
            const int hd = cw >> 6;
            const bool isq = (hd < 8) || (hd >= 20 && hd < 28);
            const bool rope = ((wc & 1) == 0) && (isq || hd == 8 || hd == 9 || hd == 12 || hd == 13 || hd == 16 || hd == 17 || (hd >= 28 && hd < 36));
            const bool gate = (hd == 44);
            const float qs = isq ? 0.125f * LOG2E : 1.0f;
            const int col = cw + 8 * fq;
#pragma unroll
            for (int ai = 0; ai < 2; ++ai)
#pragma unroll
                for (int m = 0; m < 4; ++m) {
                    const int row = row0 + ai * 128 + m * 16; const float r = row_rs(rs, row, 1.0f / 1024.0f) * qs;
                    float v[8];
#pragma unroll
                    for (int n = 0; n < 2; ++n)
#pragma unroll
                        for (int e = 0; e < 4; ++e) v[n * 4 + e] = acc[ai][bj][m][n][e] * r;
                    if (rope) {
                        const float* cs = csp + (size_t)(row & (SEQ - 1)) * 16;
                        const f32x4 c0 = *(const f32x4*)(cs), c1 = *(const f32x4*)(cs + 4), s0 = *(const f32x4*)(cs + 8), s1 = *(const f32x4*)(cs + 12);
                        const float cc[8] = {c0[0], c0[1], c0[2], c0[3], c1[0], c1[1], c1[2], c1[3]};
                        const float sn[8] = {s0[0], s0[1], s0[2], s0[3], s1[0], s1[1], s1[2], s1[3]};
#pragma unroll
                        for (int e = 0; e < 8; ++e) {
                            const float pv = __shfl_xor(v[e], 16);
                            const float o1 = v[e] * cc[e] - pv * sn[e], o2 = v[e] * cc[e] + pv * sn[e];
                            v[e] = (fq == 0) ? o1 : ((fq == 1) ? o2 : v[e]);
                        }
                    }
                    if (gate) {
#pragma unroll
                        for (int e = 0; e < 8; ++e) v[e] = sigmoid_f(v[e]);
                    }
                    u32x4 w; w.x = cvtpk(v[0], v[1]); w.y = cvtpk(v[2], v[3]); w.z = cvtpk(v[4], v[5]); w.w = cvtpk(v[6], v[7]);
                    if (gate) *(u32x4*)(PSLOT(P, C_GT) + (size_t)row * 32 + 8 * fq) = w;
                    else *(u32x4*)(PSLOT(P, cw) + (size_t)row * 64 + (col & 63)) = w;
                }
        }
    }
};
struct EpiCmp1 {
    static constexpr bool PERM = true;
    bf16_t* Hd;
    DI void operator()(const AccT& acc, const pg8::Unit& u, int wr, int wc, int fr, int fq) const {
        const int row0 = u.pm * 256 + wr * 64 + fr, col = wc * 32 + 8 * fq; const bool isv = u.pm >= 16;
#pragma unroll
        for (int ai = 0; ai < 2; ++ai)
#pragma unroll
            for (int m = 0; m < 4; ++m) {
                const int row = row0 + ai * 128 + m * 16; float v[8];
#pragma unroll
                for (int n = 0; n < 2; ++n)
#pragma unroll
                    for (int e = 0; e < 4; ++e) v[n * 4 + e] = silu_f(isv ? acc[ai][1][m][n][e] : acc[ai][0][m][n][e]);
                u32x4 w; w.x = cvtpk(v[0], v[1]); w.y = cvtpk(v[2], v[3]); w.z = cvtpk(v[4], v[5]); w.w = cvtpk(v[6], v[7]);
                *(u32x4*)(Hd + (size_t)row * 128 + col) = w;
            }
    }
};
struct EpiMlaIn {
    static constexpr bool PERM = true;
    bf16_t* C1; bf16_t* KR; const float* rs; float* rsq; float* rskv; const float* csm;
    DI void operator()(const AccT& acc, const pg8::Unit& u, int wr, int wc, int fr, int fq) const {
        const int row0 = u.pm * 256 + wr * 64 + fr;
        float rr[2][4];
#pragma unroll
        for (int ai = 0; ai < 2; ++ai)
#pragma unroll
            for (int m = 0; m < 4; ++m) rr[ai][m] = *(const GAS float*)(rs + row0 + ai * 128 + m * 16);
#pragma unroll
        for (int ai = 0; ai < 2; ++ai)
#pragma unroll
            for (int m = 0; m < 4; ++m) {
                const int row = row0 + ai * 128 + m * 16; const float r = __builtin_amdgcn_rsqf(rr[ai][m] * (1.0f / 1024.0f) + EPS);
#pragma unroll
                for (int bj = 0; bj < 2; ++bj) {
                    const int cw = u.pn * 256 + bj * 128 + wc * 32;
                    if (cw >= 416) continue;
                    const bool rope = (cw == 384);
                    float* rsacc = (cw < 256) ? rsq : rskv;
                    const int col = cw + 8 * fq;
                    float v[8];
#pragma unroll
                    for (int n = 0; n < 2; ++n)
#pragma unroll
                        for (int e = 0; e < 4; ++e) v[n * 4 + e] = acc[ai][bj][m][n][e] * r;
                    if (rope) {
                        const float* cs = csm + (size_t)(row & (SEQ - 1)) * 32 + 8 * (fq & 1);
#pragma unroll
                        for (int hf = 0; hf < 2; ++hf) {
                            const f32x4 c0 = *(const f32x4*)(cs + 4 * hf), s0 = *(const f32x4*)(cs + 16 + 4 * hf);
#pragma unroll
                            for (int e = 0; e < 4; ++e) {
                                const float x = v[hf * 4 + e]; const float pv = __shfl_xor(x, 32);
                                v[hf * 4 + e] = (fq < 2) ? (x * c0[e] - pv * s0[e]) : (x * c0[e] + pv * s0[e]);
                            }
                        }
                    } else {
                        float ss = 0.f;
#pragma unroll
                        for (int e = 0; e < 8; ++e) ss += v[e] * v[e];
                        ss += __shfl_xor(ss, 16); ss += __shfl_xor(ss, 32);
                        if (fq == 0) atomicAdd(rsacc + row, ss);
                    }
                    u32x4 w; w.x = cvtpk(v[0], v[1]); w.y = cvtpk(v[2], v[3]); w.z = cvtpk(v[4], v[5]); w.w = cvtpk(v[6], v[7]);
                    if (rope) *(u32x4*)(KR + (size_t)row * 32 + 8 * fq) = w; else *(u32x4*)(C1 + (size_t)row * 512 + col) = w;
                }
                asm volatile("" ::: "memory");
            }
    }
};
struct EpiMlaQ {
    static constexpr bool PERM = true;
    bf16_t* Q; const float* rsq; const float* csm;
    DI void operator()(const AccT& acc, const pg8::Unit& u, int wr, int wc, int fr, int fq) const {
        const int row0 = u.pm * 256 + wr * 64 + fr;
        const float qs = 0.10206207261596575f * LOG2E;
        float rr[2][4];
#pragma unroll
        for (int ai = 0; ai < 2; ++ai)
#pragma unroll
            for (int m = 0; m < 4; ++m) rr[ai][m] = *(const GAS float*)(rsq + row0 + ai * 128 + m * 16);
#pragma unroll
        for (int ai = 0; ai < 2; ++ai)
#pragma unroll
            for (int m = 0; m < 4; ++m) {
                const int row = row0 + ai * 128 + m * 16; const float r = __builtin_amdgcn_rsqf(rr[ai][m] * (1.0f / 256.0f) + EPS) * qs;
#pragma unroll
                for (int bj = 0; bj < 2; ++bj) {
                    const int cw = u.pn * 256 + bj * 128 + wc * 32;
                    const bool rope = ((cw >> 5) % 3) == 2;
                    const int col = cw + 8 * fq;
                    float v[8];
#pragma unroll
                    for (int n = 0; n < 2; ++n)
#pragma unroll
                        for (int e = 0; e < 4; ++e) v[n * 4 + e] = acc[ai][bj][m][n][e] * r;
                    if (rope) {
                        const float* cs = csm + (size_t)(row & (SEQ - 1)) * 32 + 8 * (fq & 1);
#pragma unroll
                        for (int hf = 0; hf < 2; ++hf) {
                            const f32x4 c0 = *(const f32x4*)(cs + 4 * hf), s0 = *(const f32x4*)(cs + 16 + 4 * hf);
#pragma unroll
                            for (int e = 0; e < 4; ++e) {
                                const float x = v[hf * 4 + e]; const float pv = __shfl_xor(x, 32);
                                v[hf * 4 + e] = (fq < 2) ? (x * c0[e] - pv * s0[e]) : (x * c0[e] + pv * s0[e]);
                            }
                        }
                    }
                    u32x4 w; w.x = cvtpk(v[0], v[1]); w.y = cvtpk(v[2], v[3]); w.z = cvtpk(v[4], v[5]); w.w = cvtpk(v[6], v[7]);
                    *(u32x4*)(Q + (size_t)row * 1536 + col) = w;
                }
                asm volatile("" ::: "memory");
            }
    }
};
struct EpiMlaKV {
    static constexpr bool PERM = true;
    bf16_t* KV; const float* rskv;
    DI void operator()(const AccT& acc, const pg8::Unit& u, int wr, int wc, int fr, int fq) const {
        const int row0 = u.pm * 256 + wr * 64 + fr;
        float rr[2][4];
#pragma unroll
        for (int ai = 0; ai < 2; ++ai)
#pragma unroll
            for (int m = 0; m < 4; ++m) rr[ai][m] = *(const GAS float*)(rskv + row0 + ai * 128 + m * 16);
#pragma unroll
        for (int ai = 0; ai < 2; ++ai)
#pragma unroll
            for (int m = 0; m < 4; ++m) {
                const int row = row0 + ai * 128 + m * 16; const float r = __builtin_amdgcn_rsqf(rr[ai][m] * (1.0f / 128.0f) + EPS);
#pragma unroll
                for (int bj = 0; bj < 2; ++bj) {
                    const int col = u.pn * 256 + bj * 128 + wc * 32 + 8 * fq;
                    float v[8];
#pragma unroll
                    for (int n = 0; n < 2; ++n)
#pragma unroll
                        for (int e = 0; e < 4; ++e) v[n * 4 + e] = acc[ai][bj][m][n][e] * r;
                    u32x4 w; w.x = cvtpk(v[0], v[1]); w.y = cvtpk(v[2], v[3]); w.z = cvtpk(v[4], v[5]); w.w = cvtpk(v[6], v[7]);
                    *(u32x4*)(KV + ((size_t)((row >> 14) * 16 + (col >> 7)) * SEQ + (row & (SEQ - 1))) * 128 + (col & 127)) = w;
                }
                asm volatile("" ::: "memory");
            }
    }
};

#define MFMA32(a, b, c) __builtin_amdgcn_mfma_f32_32x32x16_bf16((a), (b), (c), 0, 0, 0)
constexpr int KROWB = 208, VROWB = 192, KBUFB = 64 * KROWB, VBUFB = 64 * VROWB, TBUFB = KBUFB + VBUFB;
constexpr int ATT_LDS = 2 * TBUFB;
constexpr int IMP_OFF = 53248;
constexpr int UNI_OFF = IMP_OFF + 65536;
typedef short v4i16_t __attribute__((ext_vector_type(4)));
DI s16x4 vtr(LAS const char* p) { return __builtin_bit_cast(s16x4, __builtin_amdgcn_ds_read_tr16_b64_v4i16((LAS v4i16_t*)p)); }

#define SCHED_FENCE() __builtin_amdgcn_sched_barrier(0)
template <int NCH>
DI void qk_tile(f32x16& s0, f32x16& s1, LAS const char* Ks, const bf16x8* qf, int r, int h, const f32x16& cinit) {
    LAS const char* kb = Ks + r * KROWB + h * 16;
    bf16x8 ka[NCH], kc[NCH];
#pragma unroll
    for (int c = 0; c < NCH; ++c) { ka[c] = *(LAS const bf16x8*)(kb + c * 32); kc[c] = *(LAS const bf16x8*)(kb + 32 * KROWB + c * 32); }
    SCHED_FENCE();
#pragma unroll
    for (int c = 0; c < NCH; ++c) {
        if (c == 0) { s0 = MFMA32(ka[0], qf[0], cinit); s1 = MFMA32(kc[0], qf[0], cinit); }
        else { s0 = MFMA32(ka[c], qf[c], s0); s1 = MFMA32(kc[c], qf[c], s1); }
    }
}
DI void v_frags(bf16x8 (&vf)[8], LAS const char* Vs, int lane) {
    const int h = lane >> 5, q4 = (lane & 15) >> 2, p = lane & 3, blk = (lane >> 4) & 1;
    LAS const char* vb = Vs + (4 * h + q4) * VROWB + blk * 32 + p * 8;
#pragma unroll
    for (int dt = 0; dt < 2; ++dt)
#pragma unroll
        for (int s = 0; s < 4; ++s) {
            const s16x4 lo = vtr(vb + (16 * s) * VROWB + dt * 64);
            const s16x4 hi = vtr(vb + (16 * s + 8) * VROWB + dt * 64);
            vf[dt * 4 + s] = __builtin_shufflevector(lo, hi, 0, 1, 2, 3, 4, 5, 6, 7);
        }
}
DI void pv_mma(f32x16 (&o)[2], const bf16x8 (&vf)[8], const bf16x8 (&pf)[4]) {
#pragma unroll
    for (int s = 0; s < 4; ++s) { o[0] = MFMA32(vf[s], pf[s], o[0]); o[1] = MFMA32(vf[4 + s], pf[s], o[1]); }
}
DI void pv_tile(f32x16 (&o)[2], LAS const char* Vs, const bf16x8 (&pf)[4], int lane) {
    bf16x8 vf[8]; v_frags(vf, Vs, lane); SCHED_FENCE(); pv_mma(o, vf, pf);
}
DI void mask_tile(f32x16& s0, f32x16& s1, int lo, int hi, int h) {
    const bool empty = hi < lo; const int l2 = (empty ? 100000 : lo) - 4 * h; const unsigned span = empty ? 0u : (unsigned)(hi - lo);
#pragma unroll
    for (int i = 0; i < 16; ++i) { const int c = (i & 3) + 8 * (i >> 2);
        s0[i] = ((unsigned)(c - l2) <= span) ? s0[i] : -INFINITY;
        s1[i] = ((unsigned)(c + 32 - l2) <= span) ? s1[i] : -INFINITY; }
}
#define MX3(a, b, c) __builtin_fmaxf(__builtin_fmaxf((a), (b)), (c))
DI float tile_max(const f32x16& s0, const f32x16& s1) {
    float a = MX3(s0[0], s0[1], s0[2]), b = MX3(s1[0], s1[1], s1[2]), c = MX3(s0[3], s0[4], s0[5]), d = MX3(s1[3], s1[4], s1[5]);
    a = MX3(a, s0[6], s0[7]); b = MX3(b, s1[6], s1[7]); c = MX3(c, s0[8], s0[9]); d = MX3(d, s1[8], s1[9]);
    a = MX3(a, s0[10], s0[11]); b = MX3(b, s1[10], s1[11]); c = MX3(c, s0[12], s0[13]); d = MX3(d, s1[12], s1[13]);
    a = MX3(a, s0[14], s0[15]); b = MX3(b, s1[14], s1[15]);
    return __builtin_fmaxf(__builtin_fmaxf(a, b), __builtin_fmaxf(c, d));
}
DI float tile_max_full(const f32x16& s0, const f32x16& s1) { const float a = tile_max(s0, s1); return __builtin_fmaxf(a, __shfl_xor(a, 32)); }
DI void pack_p(bf16x8 (&pf)[4], const f32x16& s0, const f32x16& s1) {
    u32x4 w;
    w.x = cvtpk(s0[0], s0[1]); w.y = cvtpk(s0[2], s0[3]); w.z = cvtpk(s0[4], s0[5]); w.w = cvtpk(s0[6], s0[7]); pf[0] = __builtin_bit_cast(bf16x8, w);
    w.x = cvtpk(s0[8], s0[9]); w.y = cvtpk(s0[10], s0[11]); w.z = cvtpk(s0[12], s0[13]); w.w = cvtpk(s0[14], s0[15]); pf[1] = __builtin_bit_cast(bf16x8, w);
    w.x = cvtpk(s1[0], s1[1]); w.y = cvtpk(s1[2], s1[3]); w.z = cvtpk(s1[4], s1[5]); w.w = cvtpk(s1[6], s1[7]); pf[2] = __builtin_bit_cast(bf16x8, w);
    w.x = cvtpk(s1[8], s1[9]); w.y = cvtpk(s1[10], s1[11]); w.z = cvtpk(s1[12], s1[13]); w.w = cvtpk(s1[14], s1[15]); pf[3] = __builtin_bit_cast(bf16x8, w);
}
constexpr float SM_THR = 8.0f;
DI void softmax_prep(f32x16& s0, f32x16& s1, float& mref, f32x16& negm, float& l, f32x16 (&o)[2]) {
    const float mxh = tile_max(s0, s1);
    const bool unset = (mref == -INFINITY);
    if (__any(unset ? (mxh > -INFINITY) : (mxh > SM_THR))) {
        const float mx = __builtin_fmaxf(mxh, __shfl_xor(mxh, 32));
        const bool need = unset ? (mx > -INFINITY) : (mx > SM_THR);
        const float delta = need ? mx : 0.f;
        mref = (unset ? 0.f : mref) + delta; mref = (unset && !need) ? -INFINITY : mref;
        const float alpha = fexp2(-delta);
#pragma unroll
        for (int i = 0; i < 16; ++i) { s0[i] -= delta; s1[i] -= delta; o[0][i] *= alpha; o[1][i] *= alpha; }
        l *= alpha;
        const float nm = (mref == -INFINITY) ? 0.f : -mref;
#pragma unroll
        for (int i = 0; i < 16; ++i) negm[i] = nm;
    }
}
DI void softmax_exp_half(f32x16& s, float& l) {
    float sa = 0.f, sb = 0.f, sc = 0.f, sd = 0.f;
#pragma unroll
    for (int i = 0; i < 16; i += 4) { s[i] = fexp2(s[i]); s[i + 1] = fexp2(s[i + 1]); s[i + 2] = fexp2(s[i + 2]); s[i + 3] = fexp2(s[i + 3]);
        sa += s[i]; sb += s[i + 1]; sc += s[i + 2]; sd += s[i + 3]; }
    l += (sa + sb) + (sc + sd);
}
DI void pack_half(bf16x8& p0, bf16x8& p1, const f32x16& s) {
    u32x4 w;
    w.x = cvtpk(s[0], s[1]); w.y = cvtpk(s[2], s[3]); w.z = cvtpk(s[4], s[5]); w.w = cvtpk(s[6], s[7]); p0 = __builtin_bit_cast(bf16x8, w);
    w.x = cvtpk(s[8], s[9]); w.y = cvtpk(s[10], s[11]); w.z = cvtpk(s[12], s[13]); w.w = cvtpk(s[14], s[15]); p1 = __builtin_bit_cast(bf16x8, w);
}
struct TileRegs { u32x4 k, v, k2; };
template <int DQK, class V>
DI void tile_gload(TileRegs& tr, const V& v, int tile, int tid) {
    const int row = tid >> 3, ch = tid & 7;
    tr.k = *(const GAS u32x4*)(v.krow(tile, row) + ch * 16);
    tr.v = *(const GAS u32x4*)(v.vrow(tile, row) + ch * 16);
    if constexpr (DQK == 96) { if (tid < 256) tr.k2 = *(const GAS u32x4*)(v.k2row(tile, tid >> 2) + (tid & 3) * 16); }
}
template <int DQK>
DI void tile_sstore(const TileRegs& tr, LAS char* buf, int tid) {
    const int row = tid >> 3, ch = tid & 7;
    *(LAS u32x4*)(buf + row * KROWB + ch * 16) = tr.k;
    *(LAS u32x4*)(buf + KBUFB + row * VROWB + ch * 16) = tr.v;
    if constexpr (DQK == 96) { if (tid < 256) *(LAS u32x4*)(buf + (tid >> 2) * KROWB + 128 + (tid & 3) * 16) = tr.k2; }
}
template <int DQK, class V>
DI void attn_compute(const V& v, int t, LAS char* buf, const bf16x8* qf, float& mref, f32x16& negm, float& l, f32x16 (&o)[2], int lane, int r, int h) {
    int lo, hi; v.range(t, lo, hi);
    bool excl = false;
    if constexpr (V::EXCL) excl = v.excluded(t);
    const bool any = __any(!excl && (hi >= lo) && (hi >= 0) && (lo <= 63));
    if (any) {
        f32x16 s0, s1;
        if constexpr (V::EXCL) {
            f32x16 cin;
#pragma unroll
            for (int i = 0; i < 16; ++i) cin[i] = excl ? -INFINITY : negm[i];
            qk_tile<DQK / 16>(s0, s1, buf, qf, r, h, cin);
        } else {
            qk_tile<DQK / 16>(s0, s1, buf, qf, r, h, negm);
        }
        bf16x8 vf[8]; v_frags(vf, buf + KBUFB, lane);
        SCHED_FENCE();
        if (!__all(excl || ((lo <= 0) && (hi >= 63)))) mask_tile(s0, s1, lo, hi, h);
        softmax_prep(s0, s1, mref, negm, l, o);
        bf16x8 pf[4];
        softmax_exp_half(s0, l); pack_half(pf[0], pf[1], s0);
        SCHED_FENCE();
        o[0] = MFMA32(vf[0], pf[0], o[0]); o[1] = MFMA32(vf[4], pf[0], o[1]); o[0] = MFMA32(vf[1], pf[1], o[0]); o[1] = MFMA32(vf[5], pf[1], o[1]);
        SCHED_FENCE();
        softmax_exp_half(s1, l); pack_half(pf[2], pf[3], s1);
        SCHED_FENCE();
        o[0] = MFMA32(vf[2], pf[2], o[0]); o[1] = MFMA32(vf[6], pf[2], o[1]); o[0] = MFMA32(vf[3], pf[3], o[0]); o[1] = MFMA32(vf[7], pf[3], o[1]);
    }
}
template <int DQK, class V, int MODE = 3>
DI void attn_loop(const V& v, LAS char* lds, const bf16x8* qf, float& mref, float& l, f32x16 (&o)[2]) {
    const int tid = OTID(), lane = tid & 63, r = lane & 31, h = lane >> 5;
    TileRegs Ra, Rb;
    f32x16 negm;
#pragma unroll
    for (int i = 0; i < 16; ++i) negm[i] = 0.f;
    int a0 = v.first_tile();
    if (a0 < 0) return;
    int a1 = v.next_tile(a0);
    __syncthreads();
    tile_gload<DQK>(Ra, v, a0, tid); tile_gload<DQK>(Rb, v, a1 >= 0 ? a1 : a0, tid);
    tile_sstore<DQK>(Ra, lds, tid); tile_sstore<DQK>(Rb, lds + TBUFB, tid);
    __syncthreads();
    int cur = 0;
    for (;;) {
        const int b0 = (a1 >= 0) ? v.next_tile(a1) : -1;
        const int b1 = (b0 >= 0) ? v.next_tile(b0) : -1;
        tile_gload<DQK>(Ra, v, b0 >= 0 ? b0 : a0, tid); tile_gload<DQK>(Rb, v, b1 >= 0 ? b1 : a0, tid);
        LAS char* cb_ = lds + cur * (2 * TBUFB);
        LAS char* nb_ = lds + (cur ^ 1) * (2 * TBUFB);
        attn_compute<DQK>(v, a0, cb_, qf, mref, negm, l, o, lane, r, h);
        tile_sstore<DQK>(Ra, nb_, tid);
        if (a1 >= 0) attn_compute<DQK>(v, a1, cb_ + TBUFB, qf, mref, negm, l, o, lane, r, h);
        tile_sstore<DQK>(Rb, nb_ + TBUFB, tid);
        __syncthreads();
        a0 = b0; a1 = b1; cur ^= 1;
        if (a0 < 0) break;
    }
}
template <int NCH> DI void load_q(bf16x8* qf, const bf16_t* qrow, int h) {
#pragma unroll
    for (int c = 0; c < NCH; ++c) qf[c] = *(const GAS bf16x8*)(qrow + 16 * c + 8 * h);
}
DI void store_o(bf16_t* dst, const f32x16 (&o)[2], float inv, int h) {
#pragma unroll
    for (int dt = 0; dt < 2; ++dt)
#pragma unroll
        for (int g = 0; g < 4; ++g) {
            u32x2 w; w.x = cvtpk(o[dt][4 * g] * inv, o[dt][4 * g + 1] * inv); w.y = cvtpk(o[dt][4 * g + 2] * inv, o[dt][4 * g + 3] * inv);
            *(u32x2*)(dst + 32 * dt + 8 * g + 4 * h) = w;
        }
}
DI void zero_o(f32x16 (&o)[2]) {
#pragma unroll
    for (int i = 0; i < 16; ++i) { o[0][i] = 0.f; o[1][i] = 0.f; }
}

struct MlaV {
    static constexpr bool EXCL = false;
    const char* kvb; const char* krb;
    int tq, ntile, tstart;
    DI const char* krow(int t, int row) const { return kvb + (size_t)(t * 64 + row) * 256; }
    DI const char* vrow(int t, int row) const { return kvb + (size_t)(t * 64 + row) * 256 + 128; }
    DI const char* k2row(int t, int row) const { return krb + (size_t)(t * 64 + row) * 64; }
    DI int first_tile() const { return 0; }
    DI int next_tile(int t) const { return (t + 1 < ntile) ? t + 1 : -1; }
    DI void range(int t, int& lo, int& hi) const { lo = 0; hi = tq - t * 64; }
};
template <int MODE>
DI void mla_attn_phase(LAS char* lds, const bf16_t* Q, const bf16_t* KV, const bf16_t* KR, bf16_t* AO, int bid, int G) {
    const int tid = OTID(), lane = tid & 63, w = tid >> 6, r = lane & 31, h = lane >> 5;
    int k = 0;
    for (int u = bid; u < 2048; u += G, ++k) {
        const int bh = u & 31, j = u >> 5;
        const int rnd = j >> 3, jj = j & 7;
        const int qb = 63 - (rnd * 8 + ((rnd & 1) ? (7 - jj) : jj));
        const int b = bh >> 4, hd = bh & 15;
        MlaV v; v.kvb = (const char*)(KV + (size_t)(b * 16 + hd) * SEQ * 128); v.krb = (const char*)(KR + (size_t)b * SEQ * 32);
        v.ntile = 4 * qb + 4; v.tq = qb * 256 + w * 32 + r; v.tstart = (int)(((unsigned)(u >> 5) * 5u % 8u) * (unsigned)v.ntile / 8u);
        const size_t grow = (size_t)b * SEQ + v.tq;
        bf16x8 qf[6]; load_q<6>(qf, Q + grow * 1536 + hd * 96, h);
        float m = -INFINITY, l = 0.f; f32x16 o[2]; zero_o(o);
        attn_loop<96, MlaV, MODE>(v, lds, qf, m, l, o);
        const float lt = l + __shfl_xor(l, 32); const float inv = lt > 0.f ? 1.0f / lt : 0.f;
        store_o(AO + grow * 1024 + hd * 64, o, inv, h);
    }
}
struct WinV {
    static constexpr bool EXCL = false;
    const char* kb; const char* vb; int tq, t0, t1;
    DI const char* krow(int t, int row) const { return kb + (size_t)(t * 64 + row) * 128; }
    DI const char* vrow(int t, int row) const { return vb + (size_t)(t * 64 + row) * 128; }
    DI int first_tile() const { return t0; }
    DI int next_tile(int t) const { return (t + 1 <= t1) ? t + 1 : -1; }
    DI void range(int t, int& lo, int& hi) const { lo = tq - 511 - t * 64; hi = tq - t * 64; }
};
DI void win_attn_phase(LAS char* lds, const bf16_t* P, bf16_t* OW, int bid, int G) {
    const int tid = OTID(), lane = tid & 63, w = tid >> 6, r = lane & 31, h = lane >> 5;
    for (int u = bid; u < 1024; u += G) {
        const int cb = u & 255, bg = u >> 8, b = bg >> 1, g = bg & 1;
        WinV v;
        v.kb = (const char*)(PSLOT(P, C_KW + g * 64) + (size_t)b * SEQ * 64); v.vb = (const char*)(PSLOT(P, C_VW + g * 64) + (size_t)b * SEQ * 64);
        v.t0 = cb >= 8 ? cb - 8 : 0; v.t1 = cb; v.tq = cb * 64 + w * 8 + (r >> 2);
        const int hd = g * 4 + (r & 3);
        const size_t grow = (size_t)b * SEQ + v.tq;
        bf16x8 qf[4]; load_q<4>(qf, PSLOT(P, C_QA + hd * 64) + grow * 64, h);
        float m = -INFINITY, l = 0.f; f32x16 o[2]; zero_o(o);
        attn_loop<64>(v, lds, qf, m, l, o);
        const float lt = l + __shfl_xor(l, 32); const float inv = lt > 0.f ? 1.0f / lt : 0.f;
        store_o(OW + grow * 512 + hd * 64, o, inv, h);
    }
}
struct SelV {
    static constexpr bool EXCL = true;
    const char* kb; const char* vb; int tq, cb; unsigned long long u0, u1, u2, u3, m0, m1, m2, m3;
    DI const char* krow(int t, int row) const { return kb + (size_t)(t * 64 + row) * 128; }
    DI const char* vrow(int t, int row) const { return vb + (size_t)(t * 64 + row) * 128; }
    DI unsigned long long uword(int i) const { return i == 0 ? u0 : (i == 1 ? u1 : (i == 2 ? u2 : u3)); }
    DI unsigned long long tword(int i) const { return i == 0 ? m0 : (i == 1 ? m1 : (i == 2 ? m2 : m3)); }
    DI int next_tile(int t) const { for (int j = t + 1; j <= cb; ++j) if ((uword(j >> 6) >> (j & 63)) & 1ull) return j; return -1; }
    DI int first_tile() const { return next_tile(-1); }
    DI bool excluded(int t) const { return !((tword(t >> 6) >> (t & 63)) & 1ull); }
    DI void range(int t, int& lo, int& hi) const { lo = 0; hi = tq - t * 64; }
};
DI void sel_attn_phase(LAS char* lds, const bf16_t* P, const unsigned* SELM, const bf16_t* OC, const bf16_t* OW, bf16_t* AO, int bid, int G) {
    const int tid = OTID(), lane = tid & 63, w = tid >> 6, r = lane & 31, h = lane >> 5;
    LAS unsigned* uni = (LAS unsigned*)(lds + UNI_OFF);
    for (int u = bid; u < 1024; u += G) {
        const int bg = u >> 8, cb = (bg & 1) ? 255 - (u & 255) : (u & 255), b = bg >> 1, g = bg & 1;
        SelV v;
        v.kb = (const char*)(PSLOT(P, C_KS + g * 64) + (size_t)b * SEQ * 64); v.vb = (const char*)(PSLOT(P, C_VS + g * 64) + (size_t)b * SEQ * 64);
        v.cb = cb; v.tq = cb * 64 + w * 8 + (r >> 2);
        const int hl = r & 3, hd = g * 4 + hl;
        const size_t grow = (size_t)b * SEQ + v.tq;
        {
            const u32x4* sp = (const u32x4*)(SELM + ((size_t)bg * SEQ + v.tq) * 8);
            const u32x4 a = sp[0], c = sp[1];
            v.m0 = ((unsigned long long)a.y << 32) | a.x; v.m1 = ((unsigned long long)a.w << 32) | a.z;
            v.m2 = ((unsigned long long)c.y << 32) | c.x; v.m3 = ((unsigned long long)c.w << 32) | c.z;
            __syncthreads();
            if (tid < 8) uni[tid] = 0u;
            __syncthreads();
            atomicOr((unsigned*)(uni + 0), a.x); atomicOr((unsigned*)(uni + 1), a.y); atomicOr((unsigned*)(uni + 2), a.z); atomicOr((unsigned*)(uni + 3), a.w);
            atomicOr((unsigned*)(uni + 4), c.x); atomicOr((unsigned*)(uni + 5), c.y); atomicOr((unsigned*)(uni + 6), c.z); atomicOr((unsigned*)(uni + 7), c.w);
            __syncthreads();
            v.u0 = ((unsigned long long)uni[1] << 32) | uni[0]; v.u1 = ((unsigned long long)uni[3] << 32) | uni[2];
            v.u2 = ((unsigned long long)uni[5] << 32) | uni[4]; v.u3 = ((unsigned long long)uni[7] << 32) | uni[6];
        }
        bf16x8 qf[4]; load_q<4>(qf, PSLOT(P, C_QA + hd * 64) + grow * 64, h);
        float m = -INFINITY, l = 0.f; f32x16 o[2]; zero_o(o);
        attn_loop<64>(v, lds, qf, m, l, o);
        const float lt = l + __shfl_xor(l, 32); const float inv = lt > 0.f ? 1.0f / lt : 0.f;
        const bf16_t* gp = PSLOT(P, C_GT) + grow * 32 + hd * 3;
        const float gc = bf2f(gp[0]), gs = bf2f(gp[1]) * inv, gw = bf2f(gp[2]);
        const bf16_t* ocp = OC + grow * 512 + hd * 64; const bf16_t* owp = OW + grow * 512 + hd * 64; bf16_t* dst = AO + grow * 1024 + hd * 64;
#pragma unroll
        for (int dt = 0; dt < 2; ++dt)
#pragma unroll
            for (int q4 = 0; q4 < 4; ++q4) {
                const int d = 32 * dt + 8 * q4 + 4 * h;
                const u32x2 c2 = *(const u32x2*)(ocp + d), w2 = *(const u32x2*)(owp + d);
                const float r0 = gc * bflo(c2.x) + gs * o[dt][4 * q4] + gw * bflo(w2.x);
                const float r1 = gc * bfhi(c2.x) + gs * o[dt][4 * q4 + 1] + gw * bfhi(w2.x);
                const float r2 = gc * bflo(c2.y) + gs * o[dt][4 * q4 + 2] + gw * bflo(w2.y);
                const float r3 = gc * bfhi(c2.y) + gs * o[dt][4 * q4 + 3] + gw * bfhi(w2.y);
                u32x2 ww; ww.x = cvtpk(r0, r1); ww.y = cvtpk(r2, r3);
                *(u32x2*)(dst + d) = ww;
            }
    }
}

struct CmpV {
    const char* kb; const char* vb; int imax, ntile;
    DI const char* krow(int t, int row) const { return kb + (size_t)(t * 64 + row) * 128; }
    DI const char* vrow(int t, int row) const { return vb + (size_t)(t * 64 + row) * 128; }
    DI int first_tile() const { return 0; }
    DI int next_tile(int t) const { return (t + 1 < ntile) ? t + 1 : -1; }
    DI void range(int t, int& lo, int& hi) const { lo = 0; hi = imax - t * 64; }
};
DI void cmp_attn_phase(LAS char* lds, const bf16_t* P, const bf16_t* KC, const bf16_t* VC, bf16_t* OC, unsigned* SELM, int bid, int G) {
    const int tid = OTID(), lane = tid & 63, w = tid >> 6, r = lane & 31, h = lane >> 5;
    LAS float* imp = (LAS float*)(lds + IMP_OFF);
    for (int u = bid; u < 1024; u += G) {
        const int bg = u >> 8, cb = (bg & 1) ? 255 - (u & 255) : (u & 255), b = bg >> 1, g = bg & 1;
        CmpV v; v.kb = (const char*)(KC + (size_t)bg * 1024 * 64); v.vb = (const char*)(VC + (size_t)bg * 1024 * 64);
        const int cnt = (4 * cb + 3) < 1023 ? (4 * cb + 3) : 1023; v.ntile = (cnt + 63) >> 6;
        const int tq = cb * 64 + w * 8 + (r >> 2); v.imax = (tq - 31) >> 4;
        const int hd = g * 4 + (r & 3);
        const size_t grow = (size_t)b * SEQ + tq;
        bf16x8 qf[4]; load_q<4>(qf, PSLOT(P, C_QA + hd * 64) + grow * 64, h);
        f32x16 zc;
#pragma unroll
        for (int i = 0; i < 16; ++i) zc[i] = 0.f;
        float m = -INFINITY, l = 0.f;
        TileRegs tr;
        __syncthreads();
        tile_gload<64>(tr, v, 0, tid); tile_sstore<64>(tr, lds, tid);
        __syncthreads();
        int cur = 0;
        for (int t = 0; t < v.ntile; ++t) {
            const bool more = t + 1 < v.ntile;
            if (more) tile_gload<64>(tr, v, t + 1, tid);
            LAS char* buf = lds + cur * TBUFB;
            int lo, hi; v.range(t, lo, hi);
            if (__any(hi >= 0)) {
                f32x16 s0, s1; qk_tile<4>(s0, s1, buf, qf, r, h, zc);
                if (!__all(hi >= 63)) mask_tile(s0, s1, lo, hi, h);
                const float mx = tile_max_full(s0, s1); const float mn = fmaxf(m, mx); const float mu = (mn == -INFINITY) ? 0.f : mn;
                float sum = 0.f;
#pragma unroll
                for (int i = 0; i < 16; ++i) sum += fexp2(s0[i] - mu) + fexp2(s1[i] - mu);
                l = l * fexp2(m - mu) + sum; m = mn;
            }
            if (more) tile_sstore<64>(tr, lds + (cur ^ 1) * TBUFB, tid);
            __syncthreads();
            cur ^= 1;
        }
        const float lt = l + __shfl_xor(l, 32); const float inv = lt > 0.f ? 1.0f / lt : 0.f;
        const float mu = (m == -INFINITY) ? 0.f : m;
        f32x16 o[2]; zero_o(o);
        float carry = 0.f;
        tile_gload<64>(tr, v, 0, tid); tile_sstore<64>(tr, lds, tid);
        __syncthreads();
        cur = 0;
        for (int t = 0; t < v.ntile; ++t) {
            const bool more = t + 1 < v.ntile;
            if (more) tile_gload<64>(tr, v, t + 1, tid);
            LAS char* buf = lds + cur * TBUFB;
            int lo, hi; v.range(t, lo, hi);
            if (__any(hi >= 0)) {
                f32x16 s0, s1; qk_tile<4>(s0, s1, buf, qf, r, h, zc);
                if (!__all(hi >= 63)) mask_tile(s0, s1, lo, hi, h);
#pragma unroll
                for (int i = 0; i < 16; ++i) { s0[i] = fexp2(s0[i] - mu) * inv; s1[i] = fexp2(s1[i] - mu) * inv; }
                bf16x8 pf[4]; pack_p(pf, s0, s1);
                pv_tile(o, buf + KBUFB, pf, lane);
                float av[2][4], rc[2][4];
#pragma unroll
                for (int g4 = 0; g4 < 4; ++g4) {
                    av[0][g4] = 2.f * (s0[4 * g4] + s0[4 * g4 + 1] + s0[4 * g4 + 2]) + s0[4 * g4 + 3];
                    av[1][g4] = 2.f * (s1[4 * g4] + s1[4 * g4 + 1] + s1[4 * g4 + 2]) + s1[4 * g4 + 3];
                    rc[0][g4] = __shfl_xor(s0[4 * g4 + 3], 32); rc[1][g4] = __shfl_xor(s1[4 * g4 + 3], 32);
                }
#pragma unroll
                for (int sub = 0; sub < 2; ++sub)
#pragma unroll
                    for (int g4 = 0; g4 < 4; ++g4) {
                        const float prevh0 = (g4 >= 1) ? rc[sub][g4 - 1] : ((sub == 1) ? rc[0][3] : carry);
                        float val = av[sub][g4] + (h ? rc[sub][g4] : prevh0);
                        val += __shfl_xor(val, 1); val += __shfl_xor(val, 2);
                        if ((r & 3) == 0) imp[(w * 8 + (r >> 2)) * 256 + t * 16 + sub * 8 + g4 * 2 + h] = val;
                    }
                carry = rc[1][3];
            }
            if (more) tile_sstore<64>(tr, lds + (cur ^ 1) * TBUFB, tid);
            __syncthreads();
            cur ^= 1;
        }
        store_o(OC + grow * 512 + hd * 64, o, 1.0f, h);
        __syncthreads();
        const int nfree = 16 - (cb == 0 ? 1 : (cb == 1 ? 2 : 3));
        for (int tk = 0; tk < 8; ++tk) {
            const int tl = w * 8 + tk;
            unsigned vb[4]; bool cand[4], sel[4];
#pragma unroll
            for (int s = 0; s < 4; ++s) { const int j = lane + 64 * s;
                cand[s] = (j >= 1) && (j <= cb - 2);
                vb[s] = cand[s] ? __float_as_uint(imp[tl * 256 + j]) : 0u;
                sel[s] = (j == 0) || (j == cb) || (j == cb - 1); }
            unsigned thr = 0u;
            for (int bit = 30; bit >= 0; --bit) {
                const unsigned trial = thr | (1u << bit);
                int cnt = 0;
#pragma unroll
                for (int s = 0; s < 4; ++s) cnt += __popcll(__ballot(cand[s] && vb[s] >= trial));
                thr = (cnt >= nfree) ? trial : thr;
                if (cnt == nfree) break;
            }
            int cgt = 0;
#pragma unroll
            for (int s = 0; s < 4; ++s) cgt += __popcll(__ballot(cand[s] && vb[s] > thr));
            int need = nfree - cgt, pre = 0;
            const unsigned long long ltmask = (1ull << lane) - 1ull;
#pragma unroll
            for (int s = 0; s < 4; ++s) {
                const bool eq = cand[s] && (vb[s] == thr);
                const unsigned long long bm = __ballot(eq);
                const int rank = pre + __popcll(bm & ltmask);
                sel[s] = sel[s] || (cand[s] && vb[s] > thr) || (eq && rank < need);
                pre += __popcll(bm);
            }
            unsigned long long bmo[4];
#pragma unroll
            for (int s = 0; s < 4; ++s) bmo[s] = __ballot(sel[s]);
            if (lane == 0) {
                u32x4* dp = (u32x4*)(SELM + ((size_t)bg * SEQ + cb * 64 + tl) * 8);
                u32x4 a, c; a.x = (unsigned)bmo[0]; a.y = (unsigned)(bmo[0] >> 32); a.z = (unsigned)bmo[1]; a.w = (unsigned)(bmo[1] >> 32);
                c.x = (unsigned)bmo[2]; c.y = (unsigned)(bmo[2] >> 32); c.z = (unsigned)bmo[3]; c.w = (unsigned)(bmo[3] >> 32);
                dp[0] = a; dp[1] = c;
            }
        }
    }
}
struct DilV {
    static constexpr bool EXCL = false;
    const char* kb; const char* vb; size_t rstride; int pq, t0, t1;
    DI const char* krow(int t, int row) const { return kb + (size_t)(t * 64 + row) * rstride; }
    DI const char* vrow(int t, int row) const { return vb + (size_t)(t * 64 + row) * rstride; }
    DI int first_tile() const { return t0; }
    DI int next_tile(int t) const { return (t + 1 <= t1) ? t + 1 : -1; }
    DI void range(int t, int& lo, int& hi) const { lo = pq - 128 - t * 64; hi = pq - t * 64; }
};
DI void dil_attn_phase(LAS char* lds, const bf16_t* P, bf16_t* DO, float* LSE, bf16_t* AO, int br, int bid, int G) {
    const int tid = OTID(), lane = tid & 63, w = tid >> 6, r = lane & 31, h = lane >> 5;
    const int sh = 2 * br, dil = 1 << sh;
    for (int u = bid; u < 1024; u += G) {
        const int x = u & 63, bh = u >> 6, b = bh >> 3, hd = bh & 7;
        const int res = x & (dil - 1), blk = x >> sh;
        const int P0 = blk * 256;
        DilV v;
        v.kb = (const char*)(PSLOT(P, C_KB + hd * 64) + ((size_t)b * SEQ + res) * 64); v.vb = (const char*)(PSLOT(P, C_VB + hd * 64) + ((size_t)b * SEQ + res) * 64);
        v.rstride = (size_t)128 * dil;
        v.pq = P0 + w * 32 + r; v.t0 = blk * 4 >= 2 ? blk * 4 - 2 : 0; v.t1 = blk * 4 + 3;
        const int tq = v.pq * dil + res;
        const size_t grow = (size_t)b * SEQ + tq;
        bf16x8 qf[4]; load_q<4>(qf, PSLOT(P, C_QB + hd * 64) + grow * 64, h);
        float m = -INFINITY, l = 0.f; f32x16 o[2]; zero_o(o);
        attn_loop<64>(v, lds, qf, m, l, o);
        const float lt = l + __shfl_xor(l, 32); const float inv = 1.0f / lt;
        const float lse = (m + __builtin_amdgcn_logf(lt)) * LN2;
        if (br < 2) {
            store_o(DO + (size_t)br * M * 512 + grow * 512 + hd * 64, o, inv, h);
            if (h == 0) LSE[(size_t)br * M * 8 + grow * 8 + hd] = lse;
        } else {
            const float l0 = LSE[grow * 8 + hd], l1 = LSE[(size_t)M * 8 + grow * 8 + hd];
            const float mxl = fmaxf(lse, fmaxf(l0, l1));
            const float e0 = __expf(l0 - mxl), e1 = __expf(l1 - mxl), e2 = __expf(lse - mxl);
            const float is = 1.0f / (e0 + e1 + e2);
            const float w0 = e0 * is, w1 = e1 * is, w2 = e2 * is * inv;
            const bf16_t* p0 = DO + grow * 512 + hd * 64; const bf16_t* p1 = DO + (size_t)M * 512 + grow * 512 + hd * 64;
            bf16_t* dst = AO + grow * 1024 + 512 + hd * 64;
#pragma unroll
            for (int dt = 0; dt < 2; ++dt)
#pragma unroll
                for (int q4 = 0; q4 < 4; ++q4) {
                    const int d = 32 * dt + 8 * q4 + 4 * h;
                    const u32x2 a2 = *(const u32x2*)(p0 + d), b2 = *(const u32x2*)(p1 + d);
                    const float r0 = w0 * bflo(a2.x) + w1 * bflo(b2.x) + w2 * o[dt][4 * q4];
                    const float r1 = w0 * bfhi(a2.x) + w1 * bfhi(b2.x) + w2 * o[dt][4 * q4 + 1];
                    const float r2 = w0 * bflo(a2.y) + w1 * bflo(b2.y) + w2 * o[dt][4 * q4 + 2];
                    const float r3 = w0 * bfhi(a2.y) + w1 * bfhi(b2.y) + w2 * o[dt][4 * q4 + 3];
                    u32x2 ww; ww.x = cvtpk(r0, r1); ww.y = cvtpk(r2, r3);
                    *(u32x2*)(dst + d) = ww;
                }
        }
    }
}

DI float wave_sum(float v) {
#pragma unroll
    for (int o = 1; o < 64; o <<= 1) v += __shfl_xor(v, o);
    return v;
}
template <int MODE> DI int rowmap(int n) {
    if (MODE == 1) return (n >> 7) * 256 + (n & 127);
    if (MODE == 2) return (n >> 7) * 256 + 128 + (n & 127);
    if (MODE == 3) return n < 1280 ? n : (n < 1304 ? (C_GT + n - 1280) : (n - 24));
    if (MODE == 4) return n + 128;
    return n;
}
template <int MODE>
DI void tr_item(const float* W, int K, int N, bf16_t* WT, const float* gamma, LAS float* scr, int item, int lane) {
    const int nblk = (N + 63) / 64, kb = item / nblk, nb = item % nblk, k0 = 64 * kb, n0 = 64 * nb;
    const int ncol = n0 + 4 * (lane & 15), kr = lane >> 4;
    const bool okc = ncol < N;
#pragma unroll
    for (int j = 0; j < 16; ++j) { const int kk = kr + 4 * j;
        f32x4 x = okc ? *(const GAS f32x4*)(W + (size_t)(k0 + kk) * N + ncol) : (f32x4){0.f, 0.f, 0.f, 0.f};
        if (gamma) x = x * gamma[k0 + kk];
        *(LAS f32x4*)(scr + kk * 68 + 4 * (lane & 15)) = x; }
    asm volatile("s_waitcnt lgkmcnt(0)" ::: "memory");
    const int c = lane & 7;
#pragma unroll
    for (int j = 0; j < 8; ++j) { const int n = (lane >> 3) + 8 * j; const LAS float* s = scr + (8 * c) * 68 + n;
        u32x4 o; o.x = cvtpk(s[0 * 68], s[1 * 68]); o.y = cvtpk(s[2 * 68], s[3 * 68]); o.z = cvtpk(s[4 * 68], s[5 * 68]); o.w = cvtpk(s[6 * 68], s[7 * 68]);
        if (n0 + n < N) *(u32x4*)(WT + (size_t)rowmap<MODE>(n0 + n) * K + k0 + 8 * c) = o; }
    asm volatile("s_waitcnt lgkmcnt(0)" ::: "memory");
}
#define TR_JOB(MODE, Wp, Kk, Nn, WTp, gam) do { const int nit_ = ((Kk) / 64) * (((Nn) + 63) / 64); \
    int first_ = gwi - (tr_base % NGW); if (first_ < 0) first_ += NGW; tr_base += nit_; \
    for (int it_ = first_; it_ < nit_; it_ += NGW) tr_item<MODE>((Wp), (Kk), (Nn), (WTp), (gam), scr, it_, lane); } while (0)

#define XB_TMO      128
#define XB_XCNT(j)  (256  + 64 * (j))
#define XB_XSUB(j)  (1280 + 64 * (j))
#define XB_XGEN(j)  (2304 + 64 * (j))
#define XB_TOP      3328
#define XB_TOPGEN   3392
#define XCD_BAR_WORDS 3456
#define XB_SPIN_CAP (1u << 22)
DI unsigned xb_ld(unsigned* p)              { return __hip_atomic_load(p, __ATOMIC_RELAXED, __HIP_MEMORY_SCOPE_AGENT); }
DI unsigned xb_add(unsigned* p, unsigned v) { return __hip_atomic_fetch_add(p, v, __ATOMIC_RELAXED, __HIP_MEMORY_SCOPE_AGENT); }
DI unsigned xb_xcc_id() { return (unsigned)__builtin_amdgcn_s_getreg((3 << 11) | 20) & 0xFu; }
#define XB_SPIN(cond, bar) do { unsigned _sp = 0; while (cond) { __builtin_amdgcn_s_sleep(1); \
    if ((++_sp & 255u) == 0u) { if (xb_ld(&(bar)[XB_TMO])) break; if (_sp > XB_SPIN_CAP) { atomicAdd(&(bar)[XB_TMO], 1u); break; } } } } while (0)
struct XcdBarrier { unsigned* bar; unsigned x; volatile LAS unsigned* st; };
DI XcdBarrier xcd_barrier_post(unsigned* bar, volatile LAS unsigned* st) {
    XcdBarrier b; b.bar = bar; b.x = xb_xcc_id(); b.st = st;
    if (threadIdx.x == 0) (void)xb_add(&bar[XB_XCNT(b.x)], 1u);
    return b;
}
DI void xcd_barrier_complete(unsigned* bar, unsigned x, unsigned& nloc, unsigned& nx) {
    const unsigned G = gridDim.x * gridDim.y * gridDim.z;
    unsigned sum, cnt, mine, sp = 0u;
    for (;;) {
        sum = 0u; cnt = 0u; mine = 0u;
#pragma unroll
        for (unsigned j = 0; j < 16; ++j) { const unsigned c = xb_ld(&bar[XB_XCNT(j)]); sum += c; cnt += (c > 0u) ? 1u : 0u; mine = (j == x) ? c : mine; }
        if (sum == G) break;
        __builtin_amdgcn_s_sleep(1);
        if ((++sp & 255u) == 0u) { if (xb_ld(&bar[XB_TMO])) break; if (sp > XB_SPIN_CAP) { atomicAdd(&bar[XB_TMO], 1u); break; } }
    }
    nloc = mine > 0u ? mine : 1u; nx = cnt > 0u ? cnt : 1u;
}
DI void xcd_barrier(const XcdBarrier& b) {
    asm volatile("s_waitcnt vmcnt(0)" ::: "memory");
    __syncthreads();
    if (threadIdx.x == 0) {
        unsigned* bar = b.bar;
        __builtin_amdgcn_s_waitcnt(0);
        unsigned nloc = b.st[0], nx = b.st[1];
        if (nloc == 0u) { xcd_barrier_complete(bar, b.x, nloc, nx); b.st[0] = nloc; b.st[1] = nx; }
        const unsigned old = xb_add(&bar[XB_XSUB(b.x)], 1u);
        const unsigned gen = old / nloc;
        if (old + 1u == (gen + 1u) * nloc) {
            __builtin_amdgcn_fence(__ATOMIC_RELEASE, "agent");
            asm volatile("s_waitcnt vmcnt(0)" ::: "memory");
            const unsigned og = xb_add(&bar[XB_TOP], 1u);
            const unsigned tg = og / nx;
            if (og + 1u == (tg + 1u) * nx) xb_add(&bar[XB_TOPGEN], 1u);
            else XB_SPIN(xb_ld(&bar[XB_TOPGEN]) == tg, bar);
            __builtin_amdgcn_fence(__ATOMIC_ACQUIRE, "agent");
            xb_add(&bar[XB_XGEN(b.x)], 1u);
            asm volatile("s_waitcnt vmcnt(0)" ::: "memory");
        } else {
            XB_SPIN(xb_ld(&bar[XB_XGEN(b.x)]) == gen, bar);
            __builtin_amdgcn_fence(__ATOMIC_ACQUIRE, "agent");
            asm volatile("s_waitcnt vmcnt(0)" ::: "memory");
        }
    }
    __syncthreads();
}

struct Args { const float* in[25]; float* out; unsigned char* ws; };
constexpr int LDS_BYTES = 147456;
#ifndef PHM
#define PHM 0xFFFFFF
#endif
#define PHON(b) ((PHM >> (b)) & 1)
#ifndef REP_MLA
#define REP_MLA 1
#endif
#ifndef REP_EVEN
#define REP_EVEN 1
#endif
#ifndef PROBE_MODE
#define PROBE_MODE 3
#endif
#ifndef SEL_PROBE_T
#define SEL_PROBE_T 1
#endif
#ifndef REP_EIN
#define REP_EIN 1
#endif
#ifndef REP_UQKV
#define REP_UQKV 1
#endif
#ifndef REP_SEL
#define REP_SEL 1
#endif
#ifndef REP_CMP
#define REP_CMP 1
#endif
#ifndef REP_DIL
#define REP_DIL 1
#endif
#ifndef REP_WIN
#define REP_WIN 1
#endif
#ifndef REP_PRO
#define REP_PRO 1
#endif
#ifndef REP_SYNC
#define REP_SYNC 0
#endif
#ifndef REP_FFNUP
#define REP_FFNUP 1
#endif

__global__ void __launch_bounds__(512, 2) mega_fwd(Args a) {
    extern __shared__ __attribute__((aligned(16))) unsigned char lds_raw[];
    LAS unsigned char* lds = (LAS unsigned char*)lds_raw;
    cg::grid_group grid = cg::this_grid();
    const int tid = threadIdx.x, lane = tid & 63, wave = __builtin_amdgcn_readfirstlane(tid >> 6);
    const int G = gridDim.x, bid = blockIdx.x;
    volatile LAS unsigned* bst = (volatile LAS unsigned*)(lds + LDS_BYTES - 64);
    if (tid < 2) bst[tid] = 0u;
    __syncthreads();
    const XcdBarrier xbar = xcd_barrier_post((unsigned*)a.ws + 1024, bst);
#define GSYNC() xcd_barrier(xbar)
    float* X = a.out;
#define WSB ({ unsigned char* p_ = a.ws; asm volatile("" : "+s"(p_)); p_; })
#define WGU ((bf16_t*)(WSB + WS_WGU))
#define WD ((bf16_t*)(WSB + WS_WD))
#define WEI ((bf16_t*)(WSB + WS_WEI))
#define WEO ((bf16_t*)(WSB + WS_WEO))
#define WC1 ((bf16_t*)(WSB + WS_WC1))
#define WMI ((bf16_t*)(WSB + WS_WMI))
#define WUQ ((bf16_t*)(WSB + WS_WUQ))
#define WUKV ((bf16_t*)(WSB + WS_WUKV))
#define WMO ((bf16_t*)(WSB + WS_WMO))
#define CSP ((float*)(WSB + WS_CSP))
#define CSM ((float*)(WSB + WS_CSM))
#define RS ((float*)(WSB + WS_RS))
#define XB ((bf16_t*)(WSB + WS_XB))
#define AO ((bf16_t*)(WSB + WS_AO))
#define BIG ((bf16_t*)(WSB + WS_BIG))
#define MID (WSB + WS_MID)

#pragma unroll 1
    for (int rep = 0; rep < REP_PRO; ++rep)
    if (PHON(0)) {
        LAS float* scr = (LAS float*)(lds + wave * 17408);
        const int gw = bid * 8 + wave, NGW = G * 8;
        const int gwi = wave * G + bid; int tr_base = 0;
        for (int f = 0; f < 4; ++f) {
            const int l = f >> 1, sec = f & 1;
            const float* gam = a.in[sec ? 5 : 1] + (size_t)l * 1024;
            const float* wg = a.in[sec ? 6 : 2] + (size_t)l * 1024 * 2816;
            const float* wu = a.in[sec ? 7 : 3] + (size_t)l * 1024 * 2816;
            const float* wd = a.in[sec ? 8 : 4] + (size_t)l * 1024 * 2816;
            bf16_t* wgu = WGU + (size_t)f * 5632 * 1024; bf16_t* wdt = WD + (size_t)f * 1024 * 2816;
            TR_JOB(1, wg, 1024, 2816, wgu, gam);
            TR_JOB(2, wu, 1024, 2816, wgu, gam);
            TR_JOB(0, wd, 2816, 1024, wdt, (const float*)nullptr);
        }
        TR_JOB(3, a.in[10], 1024, 2840, WEI, a.in[9]);
        TR_JOB(0, a.in[11], 1024, 1024, WEO, (const float*)nullptr);
        TR_JOB(0, a.in[14], 2048, 128, WC1, (const float*)nullptr);
        TR_JOB(4, a.in[16], 2048, 128, WC1, (const float*)nullptr);
        TR_JOB(0, a.in[18], 1024, 416, WMI, a.in[9] + 1024);
        TR_JOB(0, a.in[21], 256, 1536, WUQ, a.in[19]);
        TR_JOB(0, a.in[22], 128, 2048, WUKV, a.in[20]);
        TR_JOB(0, a.in[23], 1024, 1024, WMO, (const float*)nullptr);
        const int gt = bid * 512 + tid, NGT = G * 512;
        for (int i = gt; i < 232 * 128; i += NGT) *(u32x4*)(WEI + (size_t)2840 * 1024 + (size_t)i * 8) = (u32x4){0u, 0u, 0u, 0u};
        for (int i = gt; i < 96 * 128; i += NGT) *(u32x4*)(WMI + (size_t)416 * 1024 + (size_t)i * 8) = (u32x4){0u, 0u, 0u, 0u};
        const float l2t = 18.931568569324174f;
        for (int i = gt; i < SEQ * 8; i += NGT) { const int t = i >> 3, k = i & 7;
            const float inv = exp2f(-(float)k * 0.125f * l2t); const float ang = (float)t * inv;
            const double rev = (double)ang * 0.15915494309189535; const float fr = (float)(rev - floor(rev));
            CSP[t * 16 + k] = __builtin_amdgcn_cosf(fr); CSP[t * 16 + 8 + k] = __builtin_amdgcn_sinf(fr); }
        for (int i = gt; i < SEQ * 16; i += NGT) { const int t = i >> 4, k = i & 15;
            const float inv = exp2f(-(float)k * 0.0625f * l2t); const float ang = (float)t * inv;
            const double rev = (double)ang * 0.15915494309189535; const float fr = (float)(rev - floor(rev));
            CSM[t * 32 + k] = __builtin_amdgcn_cosf(fr); CSM[t * 32 + 16 + k] = __builtin_amdgcn_sinf(fr); }
        for (int i = gt; i < 8 * M; i += NGT) RS[M + i] = 0.f;
        const float* xin = a.in[0];
        for (int m = gw; m < M; m += NGW) {
            const f32x4* xr = (const f32x4*)(xin + (size_t)m * DM) + lane; float s = 0.f; f32x4 v[4];
#pragma unroll
            for (int j = 0; j < 4; ++j) { v[j] = xr[64 * j]; s += (v[j][0] * v[j][0] + v[j][1] * v[j][1]) + (v[j][2] * v[j][2] + v[j][3] * v[j][3]); }
            s = wave_sum(s);
            u32x2* o8 = (u32x2*)(XB + (size_t)m * DM) + lane;
#pragma unroll
            for (int j = 0; j < 4; ++j) { u32x2 w; w.x = cvtpk(v[j][0], v[j][1]); w.y = cvtpk(v[j][2], v[j][3]); o8[64 * j] = w; }
            if (lane == 0) RS[m] = s;
        }
    }
    grid.sync();

#pragma unroll 1
    for (int layer = 0; layer < 2; ++layer) {
#pragma unroll 1
        for (int half = 0; half < 2; ++half) {
            if (half == 1) {
                if (layer == 0) {
                    bf16_t* PROJ = BIG;
                    bf16_t* OC = (bf16_t*)(MID + MID_OC); bf16_t* ACMP = OC; bf16_t* OW = (bf16_t*)(MID + MID_OW);
                    float* LSE = (float*)(MID + MID_LSE); unsigned* SELM = (unsigned*)(MID + MID_SELM);
                    bf16_t* HID = (bf16_t*)(MID + MID_HID); bf16_t* KC = (bf16_t*)(MID + MID_KC); bf16_t* VC = (bf16_t*)(MID + MID_VC);
                    bf16_t* DO = XB;
                    if (PHON(1)) { pg8::Gemm g{XB, WEI, M, PROJ_W, 1024, 1024}; pg8::StaticOrder S; S.init(M, PROJ_W, G, bid);
                      EpiEvenIn E{PROJ, RS + 1 * M, CSP}; pg8::gemm_phase<EpiEvenIn, true>(lds, g, S, E); }
                    GSYNC();
#pragma unroll 1
                    for (int rep = 0; rep < REP_EVEN; ++rep) {
#pragma unroll 1
                    for (int ph = 0; ph < 3; ++ph) {
                        if (ph == 0 && !PHON(2)) {} else if (ph == 0) {
                            const int gt = bid * 512 + OTID(), NGT = G * 512;
                            for (int c = gt; c < 8192 * 256; c += NGT) {
                                const int row = c >> 8, ch = c & 255, kind = row >> 12, bg = (row >> 10) & 3, i = row & 1023, b = bg >> 1, g2 = bg & 1;
                                const int lpos = ch >> 3, d0 = (ch & 7) * 8;
                                u32x4 o = (u32x4){0u, 0u, 0u, 0u};
                                if (i < 1023) {
                                    const u32x4 s = *(const u32x4*)(PSLOT(PROJ, (kind ? C_VC : C_KC) + g2 * 64) + ((size_t)b * SEQ + 16 * i + lpos) * 64 + d0);
                                    const float* pe = a.in[kind ? 13 : 12] + lpos * 64 + d0;
                                    const f32x4 p0 = *(const f32x4*)pe, p1 = *(const f32x4*)(pe + 4);
                                    o.x = cvtpk(bflo(s.x) + p0[0], bfhi(s.x) + p0[1]); o.y = cvtpk(bflo(s.y) + p0[2], bfhi(s.y) + p0[3]);
                                    o.z = cvtpk(bflo(s.z) + p1[0], bfhi(s.z) + p1[1]); o.w = cvtpk(bflo(s.w) + p1[2], bfhi(s.w) + p1[3]);
                                }
                                *(u32x4*)(ACMP + (size_t)row * 2048 + ch * 8) = o;
                            }
                        } else if (ph == 1) {
                            if (PHON(3)) { pg8::Gemm g{ACMP, WC1, 8192, 256, 2048, 2048}; pg8::StaticOrder S; S.init(8192, 256, G, bid);
                              EpiCmp1 E{HID}; pg8::gemm_phase<EpiCmp1, false>(lds, g, S, E); }
#pragma unroll 1
                            for (int rp = 0; rp < REP_WIN; ++rp)
                            if (PHON(4)) win_attn_phase((LAS char*)lds, PROJ, OW, (G > 64) ? (bid < 32 ? 1024 : bid - 32) : bid, (G > 64) ? G - 32 : G);
                        } else {
                            const int gt = bid * 512 + OTID(), NGT = G * 512;
                            for (int c = gt; c < 8192 * 8; c += NGT) {
                                const int row = c >> 3, d0 = (c & 7) * 8, kind = row >> 12;
                                const float* w2 = a.in[kind ? 17 : 15] + d0;
                                const bf16_t* hr = HID + (size_t)row * 128;
                                float acc8[8] = {0.f, 0.f, 0.f, 0.f, 0.f, 0.f, 0.f, 0.f};
                                for (int j = 0; j < 128; j += 2) {
                                    const unsigned hv = *(const unsigned*)(hr + j);
                                    const float h0 = bflo(hv), h1 = bfhi(hv);
                                    const f32x4 wa = *(const f32x4*)(w2 + (size_t)j * 64), wb = *(const f32x4*)(w2 + (size_t)j * 64 + 4);
                                    const f32x4 wc2 = *(const f32x4*)(w2 + (size_t)(j + 1) * 64), wd2 = *(const f32x4*)(w2 + (size_t)(j + 1) * 64 + 4);
#pragma unroll
                                    for (int e = 0; e < 4; ++e) { acc8[e] += h0 * wa[e] + h1 * wc2[e]; acc8[4 + e] += h0 * wb[e] + h1 * wd2[e]; }
                                }
                                u32x4 o; o.x = cvtpk(acc8[0], acc8[1]); o.y = cvtpk(acc8[2], acc8[3]); o.z = cvtpk(acc8[4], acc8[5]); o.w = cvtpk(acc8[6], acc8[7]);
                                *(u32x4*)((kind ? VC : KC) + (size_t)(row & 4095) * 64 + d0) = o;
                            }
                        }
#pragma unroll 1
                        for (int rp = 0; rp < REP_DIL; ++rp)
                        if (PHON(5)) dil_attn_phase((LAS char*)lds, PROJ, DO, LSE, AO, ph, (ph == 1 && G > 64) ? (bid < 32 ? 1024 : bid - 32) : bid, (ph == 1 && G > 64) ? G - 32 : G);
                        GSYNC();
                    }
#pragma unroll 1
                    for (int rp = 0; rp < REP_CMP; ++rp)
                    if (PHON(6)) cmp_attn_phase((LAS char*)lds, PROJ, KC, VC, OC, SELM, bid, G);
                    GSYNC();
#pragma unroll 1
                    for (int rp = 0; rp < REP_SEL; ++rp)
                    if (PHON(7)) sel_attn_phase((LAS char*)lds, PROJ, SELM, OC, OW, AO, bid, G);
                    GSYNC();
                    }
                } else {
                    bf16_t* Q = BIG; bf16_t* KV = BIG + (size_t)M * 1536; bf16_t* C1 = (bf16_t*)MID; bf16_t* KR = (bf16_t*)(MID + 32 * MiB);
                    if (PHON(8)) { pg8::Gemm g{XB, WMI, M, 512, 1024, 1024}; pg8::StaticOrder S; S.init(M, 512, G, bid);
                      EpiMlaIn E{C1, KR, RS + 4 * M, RS + 7 * M, RS + 8 * M, CSM}; pg8::gemm_phase<EpiMlaIn, true>(lds, g, S, E); }
                    GSYNC();
                    if (PHON(9)) { pg8::Gemm g{C1, WUQ, M, 1536, 256, 512}; pg8::StaticOrder S; S.init(M, 1536, G, bid);
                      EpiMlaQ E{Q, RS + 7 * M, CSM}; pg8::gemm_phase<EpiMlaQ, true>(lds, g, S, E); }
                    if (PHON(10)) { pg8::Gemm g{C1 + 256, WUKV, M, 2048, 128, 512}; pg8::StaticOrder S; S.init(M, 2048, G, bid);
                      EpiMlaKV E{KV, RS + 8 * M}; pg8::gemm_phase<EpiMlaKV, true>(lds, g, S, E); }
                    GSYNC();
#pragma unroll 1
                    for (int rep = 0; rep < REP_MLA; ++rep)
                    if (PHON(11)) { if (rep + 1 < REP_MLA) mla_attn_phase<PROBE_MODE>((LAS char*)lds, Q, KV, KR, AO, bid, G); else mla_attn_phase<3>((LAS char*)lds, Q, KV, KR, AO, bid, G); }
                    GSYNC();
                }
                if (PHON(12)) { pg8::Gemm g{AO, layer == 0 ? WEO : WMO, M, 1024, 1024, 1024}; pg8::StaticOrder S; S.init(M, 1024, G, bid);
                  EpiResid E{X, X, XB, RS + (size_t)(layer * 3 + 2) * M, 1.0f}; pg8::gemm_phase<EpiResid, true>(lds, g, S, E); }
                GSYNC();
            }
            const int f = layer * 2 + half;
            const int rs_in = layer * 3 + half * 2, rs_out = rs_in + 1;
#pragma unroll 1
            for (int rep = 0; rep < REP_FFNUP; ++rep)
            if (PHON(13)) { pg8::Gemm g{XB, WGU + (size_t)f * 5632 * 1024, M, 5632, 1024, 1024}; pg8::StaticOrder S; S.init(M, 5632, G, bid);
              EpiSwiglu E{BIG, RS + (size_t)rs_in * M}; pg8::gemm_phase<EpiSwiglu, true>(lds, g, S, E); }
            GSYNC();
            if (PHON(14)) { pg8::Gemm g{BIG, WD + (size_t)f * 1024 * 2816, M, 1024, 2816, 2816}; pg8::StaticOrder S; S.init(M, 1024, G, bid);
              EpiResid E{(layer == 0 && half == 0) ? a.in[0] : X, X, (layer == 1 && half == 1) ? (bf16_t*)nullptr : XB, RS + (size_t)rs_out * M, 0.5f}; pg8::gemm_phase<EpiResid, true>(lds, g, S, E); }
            GSYNC();
        }
    }
#pragma unroll 1
    for (int rep = 0; rep < REP_SYNC; ++rep) GSYNC();
    {
        const int lane = OTID() & 63; const int gw = bid * 8 + wave, NGW = G * 8;
        const float* gf = a.in[24]; const float* rs = RS + 6 * M;
        for (int m = gw; m < M; m += NGW) {
            const float r = __builtin_amdgcn_rsqf(rs[m] * (1.0f / 1024.0f) + EPS);
            f32x4* xr = (f32x4*)(X + (size_t)m * DM) + lane; const f32x4* gr = (const f32x4*)gf + lane;
#pragma unroll
            for (int j = 0; j < 4; ++j) { const f32x4 v = xr[64 * j]; const f32x4 gg = gr[64 * j]; xr[64 * j] = v * r * gg; }
        }
    }
}

extern "C" void kernel_launch(void* const* d_in, const int* in_sizes, int n_in, void* d_out, int out_size, void* d_ws, size_t ws_size, hipStream_t stream) {
    static int grid = 0;
    if (grid == 0) {
        if (n_in != 25 || out_size != M * DM || ws_size < WS_END) { fprintf(stderr, "kernel_launch: unexpected sizes n_in %d out %d ws %zu (need %zu)\n", n_in, out_size, ws_size, (size_t)WS_END); grid = -1; return; }
        int dev = 0, cus = 0, per_cu = 0;
        hipGetDevice(&dev); hipDeviceGetAttribute(&cus, hipDeviceAttributeMultiprocessorCount, dev);
        if (hipFuncSetAttribute((const void*)mega_fwd, hipFuncAttributeMaxDynamicSharedMemorySize, LDS_BYTES) != hipSuccess) { fprintf(stderr, "kernel_launch: hipFuncSetAttribute failed\n"); grid = -1; return; }
        hipOccupancyMaxActiveBlocksPerMultiprocessor(&per_cu, (const void*)mega_fwd, 512, LDS_BYTES);
        if (per_cu < 1) { fprintf(stderr, "kernel_launch: occupancy query says %d blocks per CU\n", per_cu); per_cu = 1; }
        (void)hipGetLastError();
        grid = cus;
    }
    if (grid < 0) return;
    if (hipMemsetAsync(d_ws, 0, 65536, stream) != hipSuccess) { fprintf(stderr, "kernel_launch: memset of the barrier words failed\n"); return; }
    Args a{};
    for (int i = 0; i < 25; ++i) a.in[i] = (const float*)d_in[i];
    a.out = (float*)d_out; a.ws = (unsigned char*)d_ws;
    void* args[] = {&a};
    hipError_t e = hipLaunchCooperativeKernel((const void*)mega_fwd, dim3(grid), dim3(512), args, LDS_BYTES, stream);
    if (e != hipSuccess) fprintf(stderr, "cooperative launch failed: %s (grid %d)\n", hipGetErrorString(e), grid);
}
```

```cpp
#include <hip/hip_runtime.h>
#include <hip/hip_cooperative_groups.h>
#include <cstdio>
#include <cstdint>
namespace cg = cooperative_groups;

#define DI __device__ __forceinline__
#define LAS __attribute__((address_space(3)))
#define GAS __attribute__((address_space(1)))
#define OTID() ({ int t_ = threadIdx.x; asm volatile("" : "+v"(t_)); t_; })
typedef unsigned short bf16_t;
typedef short bf16x8 __attribute__((ext_vector_type(8)));
typedef short s16x4 __attribute__((ext_vector_type(4)));
typedef float f32x4 __attribute__((ext_vector_type(4)));
typedef float f32x2 __attribute__((ext_vector_type(2)));
typedef float f32x16 __attribute__((ext_vector_type(16)));
typedef unsigned u32x4 __attribute__((ext_vector_type(4)));
typedef unsigned u32x2 __attribute__((ext_vector_type(2)));
typedef __bf16 bf16x2_t __attribute__((ext_vector_type(2)));

DI unsigned cvtpk(float lo, float hi) { f32x2 v = {lo, hi}; bf16x2_t b = __builtin_convertvector(v, bf16x2_t); return __builtin_bit_cast(unsigned, b); }
DI float bf2f(unsigned short u) { return __uint_as_float(((unsigned)u) << 16); }
DI float bflo(unsigned u) { return __uint_as_float(u << 16); }
DI float bfhi(unsigned u) { return __uint_as_float(u & 0xffff0000u); }
DI float fexp2(float x) { return __builtin_amdgcn_exp2f(x); }
DI float frcp(float x) { return __builtin_amdgcn_rcpf(x); }
DI float silu_f(float x) { return x * frcp(1.0f + fexp2(-1.4426950408889634f * x)); }
DI float sigmoid_f(float x) { return frcp(1.0f + fexp2(-1.4426950408889634f * x)); }

constexpr int SEQ = 16384, NB = 2, M = NB * SEQ, DM = 1024, DFF = 2816;
constexpr float EPS = 1e-6f;
constexpr float LOG2E = 1.4426950408889634f, LN2 = 0.6931471805599453f;
constexpr int PROJ_W = 3072;
#define PSLOT(P, col) ((P) + (size_t)((col) >> 6) * M * 64)
constexpr int C_QA = 0, C_KC = 512, C_VC = 640, C_KS = 768, C_VS = 896, C_KW = 1024, C_VW = 1152, C_QB = 1280, C_KB = 1792, C_VB = 2304, C_GT = 2816;

constexpr size_t MiB = 1u << 20;
constexpr size_t SZ_WGU = (size_t)5632 * 1024 * 2, SZ_WD = (size_t)1024 * 2816 * 2;
constexpr size_t WS_WGU = 1 * MiB;
constexpr size_t WS_WD = WS_WGU + 4 * SZ_WGU;
constexpr size_t WS_WEI = WS_WD + 4 * SZ_WD;
constexpr size_t WS_WEO = WS_WEI + (size_t)3072 * 1024 * 2;
constexpr size_t WS_WC1 = WS_WEO + (size_t)1024 * 1024 * 2;
constexpr size_t WS_WMI = WS_WC1 + (size_t)256 * 2048 * 2;
constexpr size_t WS_WUQ = WS_WMI + (size_t)512 * 1024 * 2;
constexpr size_t WS_WUKV = WS_WUQ + (size_t)1536 * 256 * 2;
constexpr size_t WS_WMO = WS_WUKV + (size_t)2048 * 128 * 2;
constexpr size_t WS_CSP = WS_WMO + (size_t)1024 * 1024 * 2;
constexpr size_t WS_CSM = WS_CSP + (size_t)SEQ * 16 * 4;
constexpr size_t WS_RS = WS_CSM + (size_t)SEQ * 32 * 4;
constexpr size_t WS_XB = ((WS_RS + (size_t)9 * M * 4 + MiB - 1) / MiB) * MiB;
constexpr size_t WS_AO = WS_XB + (size_t)M * 1024 * 2;
constexpr size_t WS_BIG = WS_AO + (size_t)M * 1024 * 2;
constexpr size_t WS_MID = WS_BIG + 224 * MiB;
constexpr size_t WS_END = WS_MID + 72 * MiB;
constexpr size_t MID_OC = 0, MID_OW = 32 * MiB, MID_LSE = 64 * MiB, MID_SELM = 66 * MiB, MID_HID = 68 * MiB, MID_KC = 70 * MiB, MID_VC = 70 * MiB + 512 * 1024;

namespace pg8 {
constexpr int BM = 256, BK = 64, HALF = 128, HTB = HALF * BK * 2, STAGE_BYTES = 8 * HTB, NXCD = 8, WGM = 8;
DI int lds_byte(int r, int c) { const int st = (r >> 4) * 2 + (c >> 5), rr = r & 15, cc = c & 31, ob = rr * 64 + cc * 2; return st * 1024 + (ob ^ (((ob >> 9) & 1) << 5)); }
DI void stage_rc(int b, int& R, int& C) { const int st = b / 1024, sb = b % 1024, swz = sb ^ (((sb >> 9) & 1) << 5); R = (st >> 1) * 16 + swz / 64; C = (st & 1) * 32 + (swz % 64) / 2; }
DI int perm32(int rho) { const int n = rho >> 4, i = rho & 15; return 8 * (i >> 2) + 4 * n + (i & 3); }
struct Unit { int pm, pn; };
struct Gemm { const bf16_t* A; const bf16_t* Bt; int M, N, K, lda; };
struct StaticOrder {
    int nM, nN, nwg, G, c;
    DI void init(int M_, int N_, int G_, int c_) { nM = M_ / BM; nN = N_ / BM; nwg = nM * nN; G = G_; c = c_; }
    DI bool next(int i, Unit& u) const {
        const long L = (long)i * G + c; if (L >= nwg) return false;
        int wgid = (int)L; { const int q = nwg / NXCD, r = nwg % NXCD, xcd = wgid % NXCD, off = wgid / NXCD; wgid = (xcd < r ? xcd * (q + 1) : r * (q + 1) + (xcd - r) * q) + off; }
        const int nig = WGM * nN, gid = wgid / nig, fm = gid * WGM, gsz = (nM - fm) < WGM ? (nM - fm) : WGM;
        u.pm = fm + ((wgid % nig) % gsz); u.pn = (wgid % nig) / gsz; return true;
    }
};
template <class Epi, bool ALIGN_EPI>
DI void gemm_phase(LAS unsigned char* lds, const Gemm g, const StaticOrder& S, const Epi& E) {
    int tid_ = threadIdx.x; asm volatile("" : "+v"(tid_));
    const int tid = tid_, wid = __builtin_amdgcn_readfirstlane(tid >> 6), lane = tid & 63, wr = wid >> 2, wc = wid & 3, fr = lane & 15, fq = lane >> 4;
    int K_ = g.K, lda_ = g.lda; asm volatile("" : "+s"(K_), "+s"(lda_));
    const int K = K_, nt = K / BK, lda = lda_;
    unsigned voffA[2], voffB[2];
#pragma unroll
    for (int i = 0; i < 2; ++i) { int R, C; stage_rc(tid * 16 + i * 8192, R, C); const int Rb = Epi::PERM ? ((R & ~31) + perm32(R & 31)) : R;
        voffA[i] = (unsigned)(R * lda + C) * 2u; voffB[i] = (unsigned)(Rb * K + C) * 2u; }
    const size_t kstep = (size_t)(BK * 2);
    const size_t hstepA = (size_t)HALF * lda * 2, hstepB = (size_t)HALF * K * 2;
    const size_t tstepA = 2 * hstepA, tstepB = 2 * hstepB;
    const unsigned ldsw = (unsigned)wid * 1024u;
    const int aoff = lds_byte(wr * 64 + fr, fq * 8), boff = lds_byte(wc * 32 + fr, fq * 8);
#define PG8_SA(b, h) (((b) * 2 + (h)) * HTB)
#define PG8_SB(b, h) ((4 + (b) * 2 + (h)) * HTB)
#define PG8_STAGE(bufoff, gbase, voff) do { _Pragma("unroll") for (int _i = 0; _i < 2; ++_i) \
        __builtin_amdgcn_global_load_lds((const unsigned*)((const char*)(gbase) + (voff)[_i]), (LAS unsigned*)(lds + (bufoff) + ldsw + _i * 8192), 16, 0, 0); } while (0)
#define PG8_LDA(dst, b, h) do { _Pragma("unroll") for (int m = 0; m < 4; ++m) _Pragma("unroll") for (int k = 0; k < 2; ++k) dst[m][k] = *(const LAS bf16x8*)(lds + PG8_SA(b, h) + aoff + m * 2048 + k * 1024); } while (0)
#define PG8_LDB(dst, b, h) do { _Pragma("unroll") for (int n = 0; n < 2; ++n) _Pragma("unroll") for (int k = 0; k < 2; ++k) dst[n][k] = *(const LAS bf16x8*)(lds + PG8_SB(b, h) + boff + n * 2048 + k * 1024); } while (0)
#define PG8_MMA(ai, bj, At, Bt) do { __builtin_amdgcn_s_setprio(1); _Pragma("unroll") for (int m = 0; m < 4; ++m) _Pragma("unroll") for (int n = 0; n < 2; ++n) _Pragma("unroll") for (int k = 0; k < 2; ++k) \
        acc[ai][bj][m][n] = __builtin_amdgcn_mfma_f32_16x16x32_bf16(Bt[n][k], At[m][k], acc[ai][bj][m][n], 0, 0, 0); __builtin_amdgcn_s_setprio(0); } while (0)
#define PG8_WAIT_V(n) asm volatile("s_waitcnt vmcnt(" #n ")" ::: "memory")
#define PG8_WAIT_L(n) asm volatile("s_waitcnt lgkmcnt(" #n ")" ::: "memory")
#define PG8_BAR __builtin_amdgcn_s_barrier()
#define PG8_SCHED __builtin_amdgcn_sched_barrier(0)
    Unit cur, nxt; int ui = 0;
    if (!S.next(0, cur)) return;
    f32x4 acc[2][2][4][2];
#pragma unroll
    for (int a = 0; a < 2; ++a)
#pragma unroll
        for (int b = 0; b < 2; ++b)
#pragma unroll
            for (int m = 0; m < 4; ++m)
#pragma unroll
                for (int n = 0; n < 2; ++n) acc[a][b][m][n] = (f32x4){0.f, 0.f, 0.f, 0.f};
    bf16x8 At[4][2], B0[2][2], B1[2][2];
    const char* cA = (const char*)g.A + (size_t)cur.pm * tstepA; const char* cB = (const char*)g.Bt + (size_t)cur.pn * tstepB;
    PG8_STAGE(PG8_SB(0, 0), cB, voffB); PG8_STAGE(PG8_SB(0, 1), cB + hstepB, voffB); PG8_STAGE(PG8_SA(0, 0), cA, voffA); PG8_STAGE(PG8_SA(0, 1), cA + hstepA, voffA);
    if (wr == 1) PG8_BAR;
    PG8_WAIT_V(2); PG8_BAR;
    PG8_STAGE(PG8_SB(1, 0), cB + kstep, voffB); PG8_STAGE(PG8_SA(1, 0), cA + kstep, voffA); PG8_STAGE(PG8_SB(1, 1), cB + hstepB + kstep, voffB);
    PG8_WAIT_V(6); PG8_BAR;
    for (;;) {
        const bool has_next = S.next(ui + 1, nxt);
        const char* nA = has_next ? (const char*)g.A + (size_t)nxt.pm * tstepA : cA; const char* nB = has_next ? (const char*)g.Bt + (size_t)nxt.pn * tstepB : cB;
        for (int t = 0; t < nt; t += 2) {
            const bool last = (t == nt - 2);
            const char* a1 = cA + (size_t)(t + 1) * kstep;
            const char* a2 = last ? nA : cA + (size_t)(t + 2) * kstep; const char* b2 = last ? nB : cB + (size_t)(t + 2) * kstep;
            const char* a3 = a2 + kstep; const char* b3 = b2 + kstep;
            PG8_LDB(B0, 0, 0); PG8_LDB(B1, 0, 1); PG8_SCHED; PG8_LDA(At, 0, 0); PG8_STAGE(PG8_SA(1, 1), a1 + hstepA, voffA);
            PG8_WAIT_V(8); PG8_WAIT_L(0); PG8_BAR; PG8_MMA(0, 0, At, B0); PG8_MMA(0, 1, At, B1); PG8_BAR; PG8_SCHED;
            PG8_LDA(At, 0, 1); PG8_STAGE(PG8_SB(0, 0), b2, voffB); PG8_STAGE(PG8_SB(0, 1), b2 + hstepB, voffB); PG8_STAGE(PG8_SA(0, 0), a2, voffA);
            PG8_WAIT_V(8); PG8_WAIT_L(0); PG8_BAR; PG8_MMA(1, 0, At, B0); PG8_MMA(1, 1, At, B1); PG8_BAR; PG8_SCHED;
            PG8_LDB(B0, 1, 0); PG8_LDB(B1, 1, 1); PG8_SCHED; PG8_LDA(At, 1, 0); PG8_STAGE(PG8_SA(0, 1), a2 + hstepA, voffA);
            PG8_WAIT_V(8); PG8_WAIT_L(0); PG8_BAR; PG8_MMA(0, 0, At, B0); PG8_MMA(0, 1, At, B1); PG8_BAR; PG8_SCHED;
            PG8_LDA(At, 1, 1); PG8_STAGE(PG8_SB(1, 0), b3, voffB); PG8_STAGE(PG8_SB(1, 1), b3 + hstepB, voffB); PG8_STAGE(PG8_SA(1, 0), a3, voffA);
            PG8_WAIT_V(8); PG8_WAIT_L(0); PG8_BAR; PG8_MMA(1, 0, At, B0); PG8_MMA(1, 1, At, B1); PG8_BAR; PG8_SCHED;
        }
        if constexpr (ALIGN_EPI) { if (wr == 0) PG8_BAR; }
        E(acc, cur, wr, wc, fr, fq);
        if (!has_next) break;
#pragma unroll
        for (int a = 0; a < 2; ++a)
#pragma unroll
            for (int b = 0; b < 2; ++b)
#pragma unroll
                for (int m = 0; m < 4; ++m)
#pragma unroll
                    for (int n = 0; n < 2; ++n) acc[a][b][m][n] = (f32x4){0.f, 0.f, 0.f, 0.f};
        cur = nxt; cA = nA; cB = nB; ++ui;
        if constexpr (ALIGN_EPI) { if (wr == 1) PG8_BAR; }
    }
    PG8_WAIT_V(0);
    if constexpr (!ALIGN_EPI) { if (wr == 0) PG8_BAR; }
    PG8_BAR;
#undef PG8_SA
#undef PG8_SB
#undef PG8_STAGE
#undef PG8_LDA
#undef PG8_LDB
#undef PG8_MMA
#undef PG8_WAIT_V
#undef PG8_WAIT_L
#undef PG8_BAR
#undef PG8_SCHED
}
}

typedef f32x4 AccT[2][2][4][2];
DI float row_rs(const float* rs, int row, float invn) { return __builtin_amdgcn_rsqf(rs[row] * invn + EPS); }

struct EpiSwiglu {
    static constexpr bool PERM = true;
    bf16_t* H; const float* rs;
    DI void operator()(const AccT& acc, const pg8::Unit& u, int wr, int wc, int fr, int fq) const {
        const int row0 = u.pm * 256 + wr * 64 + fr, col = u.pn * 128 + wc * 32 + 8 * fq;
        float rr[2][4];
#pragma unroll
        for (int ai = 0; ai < 2; ++ai)
#pragma unroll
            for (int m = 0; m < 4; ++m) rr[ai][m] = *(const GAS float*)(rs + row0 + ai * 128 + m * 16);
#pragma unroll
        for (int ai = 0; ai < 2; ++ai)
#pragma unroll
            for (int m = 0; m < 4; ++m) {
                const int row = row0 + ai * 128 + m * 16; const float r = __builtin_amdgcn_rsqf(rr[ai][m] * (1.0f / 1024.0f) + EPS);
                float hv[8];
#pragma unroll
                for (int n = 0; n < 2; ++n)
#pragma unroll
                    for (int e = 0; e < 4; ++e) { const float gv = acc[ai][0][m][n][e] * r, uv = acc[ai][1][m][n][e] * r; hv[n * 4 + e] = silu_f(gv) * uv; }
                u32x4 w; w.x = cvtpk(hv[0], hv[1]); w.y = cvtpk(hv[2], hv[3]); w.z = cvtpk(hv[4], hv[5]); w.w = cvtpk(hv[6], hv[7]);
                *(GAS u32x4*)(H + (size_t)row * DFF + col) = w;
            }
    }
};
struct EpiResid {
    static constexpr bool PERM = false;
    const float* base; float* out; bf16_t* xb; float* rs_out; float coef;
    DI void operator()(const AccT& acc, const pg8::Unit& u, int wr, int wc, int fr, int fq) const {
        const int row0 = u.pm * 256 + wr * 64 + fr, col0 = u.pn * 256 + wc * 32 + 4 * fq;
#pragma unroll
        for (int ai = 0; ai < 2; ++ai)
#pragma unroll
            for (int m = 0; m < 4; ++m) {
                const int row = row0 + ai * 128 + m * 16; const size_t off = (size_t)row * DM + col0; float ss = 0.f;
#pragma unroll
                for (int bj = 0; bj < 2; ++bj)
#pragma unroll
                    for (int n = 0; n < 2; ++n) {
                        const f32x4 bs = *(const f32x4*)(base + off + bj * 128 + n * 16);
                        const f32x4 v = bs + acc[ai][bj][m][n] * coef;
                        *(f32x4*)(out + off + bj * 128 + n * 16) = v;
                        if (xb) { u32x2 w; w.x = cvtpk(v[0], v[1]); w.y = cvtpk(v[2], v[3]); *(u32x2*)(xb + off + bj * 128 + n * 16) = w; }
                        ss += (v[0] * v[0] + v[1] * v[1]) + (v[2] * v[2] + v[3] * v[3]);
                    }
                ss += __shfl_xor(ss, 16); ss += __shfl_xor(ss, 32);
                if (fq == 0) atomicAdd(rs_out + row, ss);
            }
    }
};
struct EpiEvenIn {
    static constexpr bool PERM = true;
    bf16_t* P; const float* rs; const float* csp;
    DI void operator()(const AccT& acc, const pg8::Unit& u, int wr, int wc, int fr, int fq) const {
        const int row0 = u.pm * 256 + wr * 64 + fr;
#pragma unroll
        for (int bj = 0; bj < 2; ++bj) {
            const int cw = u.pn * 256 + bj * 128 + wc * 32;
            if (cw >= 2848) continue;
            const int hd = cw >> 6;
            const bool isq = (hd < 8) || (hd >= 20 && hd < 28);
            const bool rope = ((wc & 1) == 0) && (isq || hd == 8 || hd == 9 || hd == 12 || hd == 13 || hd == 16 || hd == 17 || (hd >= 28 && hd < 36));
            const bool gate = (hd == 44);
            const float qs = isq ? 0.125f * LOG2E : 1.0f;
            const int col = cw + 8 * fq;
#pragma unroll
            for (int ai = 0; ai < 2; ++ai)
#pragma unroll
                for (int m = 0; m < 4; ++m) {
                    const int row = row0 + ai * 128 + m * 16; const float r = row_rs(rs, row, 1.0f / 1024.0f) * qs;
                    float v[8];
#pragma unroll
                    for (int n = 0; n < 2; ++n)
#pragma unroll
                        for (int e = 0; e < 4; ++e) v[n * 4 + e] = acc[ai][bj][m][n][e] * r;
                    if (rope) {
                        const float* cs = csp + (size_t)(row & (SEQ - 1)) * 16;
                        const f32x4 c0 = *(const f32x4*)(cs), c1 = *(const f32x4*)(cs + 4), s0 = *(const f32x4*)(cs + 8), s1 = *(const f32x4*)(cs + 12);
                        const float cc[8] = {c0[0], c0[1], c0[2], c0[3], c1[0], c1[1], c1[2], c1[3]};
                        const float sn[8] = {s0[0], s0[1], s0[2], s0[3], s1[0], s1[1], s1[2], s1[3]};
#pragma unroll
                        for (int e = 0; e < 8; ++e) {
                            const float pv = __shfl_xor(v[e], 16);
                            const float o1 = v[e] * cc[e] - pv * sn[e], o2 = v[e] * cc[e] + pv * sn[e];
                            v[e] = (fq == 0) ? o1 : ((fq == 1) ? o2 : v[e]);
                        }
                    }
                    if (gate) {
#pragma unroll
                        for (int e = 0; e < 8; ++e) v[e] = sigmoid_f(v[e]);
                    }
                    u32x4 w; w.x = cvtpk(v[0], v[1]); w.y = cvtpk(v[2], v[3]); w.z = cvtpk(v[4], v[5]); w.w = cvtpk(v[6], v[7]);
                    if (gate) *(u32x4*)(PSLOT(P, C_GT) + (size_t)row * 32 + 8 * fq) = w;
                    else *(u32x4*)(PSLOT(P, cw) + (size_t)row * 64 + (col & 63)) = w;
                }
        }
    }
};
struct EpiCmp1 {
    static constexpr bool PERM = true;
    bf16_t* Hd;
    DI void operator()(const AccT& acc, const pg8::Unit& u, int wr, int wc, int fr, int fq) const {
        const int row0 = u.pm * 256 + wr * 64 + fr, col = wc * 32 + 8 * fq; const bool isv = u.pm >= 16;
#pragma unroll
        for (int ai = 0; ai < 2; ++ai)
#pragma unroll
            for (int m = 0; m < 4; ++m) {
                const int row = row0 + ai * 128 + m * 16; float v[8];
#pragma unroll
                for (int n = 0; n < 2; ++n)
#pragma unroll
                    for (int e = 0; e < 4; ++e) v[n * 4 + e] = silu_f(isv ? acc[ai][1][m][n][e] : acc[ai][0][m][n][e]);
                u32x4 w; w.x = cvtpk(v[0], v[1]); w.y = cvtpk(v[2], v[3]); w.z = cvtpk(v[4], v[5]); w.w = cvtpk(v[6], v[7]);
                *(u32x4*)(Hd + (size_t)row * 128 + col) = w;
            }
    }
};
struct EpiMlaIn {
    static constexpr bool PERM = true;
    bf16_t* C1; bf16_t* KR; const float* rs; float* rsq; float* rskv; const float* csm;
    DI void operator()(const AccT& acc, const pg8::Unit& u, int wr, int wc, int fr, int fq) const {
        const int row0 = u.pm * 256 + wr * 64 + fr;
#pragma unroll
        for (int ai = 0; ai < 2; ++ai)
#pragma unroll
            for (int m = 0; m < 4; ++m) {
                const int row = row0 + ai * 128 + m * 16; const float r = row_rs(rs, row, 1.0f / 1024.0f);
#pragma unroll
                for (int bj = 0; bj < 2; ++bj) {
                    const int cw = u.pn * 256 + bj * 128 + wc * 32;
                    if (cw >= 416) continue;
                    const bool rope = (cw == 384);
                    float* rsacc = (cw < 256) ? rsq : rskv;
                    const int col = cw + 8 * fq;
                    float v[8];
#pragma unroll
                    for (int n = 0; n < 2; ++n)
#pragma unroll
                        for (int e = 0; e < 4; ++e) v[n * 4 + e] = acc[ai][bj][m][n][e] * r;
                    if (rope) {
                        const float* cs = csm + (size_t)(row & (SEQ - 1)) * 32 + 8 * (fq & 1);
#pragma unroll
                        for (int hf = 0; hf < 2; ++hf) {
                            const f32x4 c0 = *(const f32x4*)(cs + 4 * hf), s0 = *(const f32x4*)(cs + 16 + 4 * hf);
#pragma unroll
                            for (int e = 0; e < 4; ++e) {
                                const float x = v[hf * 4 + e]; const float pv = __shfl_xor(x, 32);
                                v[hf * 4 + e] = (fq < 2) ? (x * c0[e] - pv * s0[e]) : (x * c0[e] + pv * s0[e]);
                            }
                        }
                    } else {
                        float ss = 0.f;
#pragma unroll
                        for (int e = 0; e < 8; ++e) ss += v[e] * v[e];
                        ss += __shfl_xor(ss, 16); ss += __shfl_xor(ss, 32);
                        if (fq == 0) atomicAdd(rsacc + row, ss);
                    }
                    u32x4 w; w.x = cvtpk(v[0], v[1]); w.y = cvtpk(v[2], v[3]); w.z = cvtpk(v[4], v[5]); w.w = cvtpk(v[6], v[7]);
                    if (rope) *(u32x4*)(KR + (size_t)row * 32 + 8 * fq) = w; else *(u32x4*)(C1 + (size_t)row * 512 + col) = w;
                }
                asm volatile("" ::: "memory");
            }
    }
};
struct EpiMlaQ {
    static constexpr bool PERM = true;
    bf16_t* Q; const float* rsq; const float* csm;
    DI void operator()(const AccT& acc, const pg8::Unit& u, int wr, int wc, int fr, int fq) const {
        const int row0 = u.pm * 256 + wr * 64 + fr;
        const float qs = 0.10206207261596575f * LOG2E;
#pragma unroll
        for (int ai = 0; ai < 2; ++ai)
#pragma unroll
            for (int m = 0; m < 4; ++m) {
                const int row = row0 + ai * 128 + m * 16; const float r = row_rs(rsq, row, 1.0f / 256.0f) * qs;
#pragma unroll
                for (int bj = 0; bj < 2; ++bj) {
                    const int cw = u.pn * 256 + bj * 128 + wc * 32;
                    const bool rope = ((cw >> 5) % 3) == 2;
                    const int col = cw + 8 * fq;
                    float v[8];
#pragma unroll
                    for (int n = 0; n < 2; ++n)
#pragma unroll
                        for (int e = 0; e < 4; ++e) v[n * 4 + e] = acc[ai][bj][m][n][e] * r;
                    if (rope) {
                        const float* cs = csm + (size_t)(row & (SEQ - 1)) * 32 + 8 * (fq & 1);
#pragma unroll
                        for (int hf = 0; hf < 2; ++hf) {
                            const f32x4 c0 = *(const f32x4*)(cs + 4 * hf), s0 = *(const f32x4*)(cs + 16 + 4 * hf);
#pragma unroll
                            for (int e = 0; e < 4; ++e) {
                                const float x = v[hf * 4 + e]; const float pv = __shfl_xor(x, 32);
                                v[hf * 4 + e] = (fq < 2) ? (x * c0[e] - pv * s0[e]) : (x * c0[e] + pv * s0[e]);
                            }
                        }
                    }
                    u32x4 w; w.x = cvtpk(v[0], v[1]); w.y = cvtpk(v[2], v[3]); w.z = cvtpk(v[4], v[5]); w.w = cvtpk(v[6], v[7]);
                    *(u32x4*)(Q + (size_t)row * 1536 + col) = w;
                }
                asm volatile("" ::: "memory");
            }
    }
};
struct EpiMlaKV {
    static constexpr bool PERM = true;
    bf16_t* KV; const float* rskv;
    DI void operator()(const AccT& acc, const pg8::Unit& u, int wr, int wc, int fr, int fq) const {
        const int row0 = u.pm * 256 + wr * 64 + fr;
#pragma unroll
        for (int ai = 0; ai < 2; ++ai)
#pragma unroll
            for (int m = 0; m < 4; ++m) {
                const int row = row0 + ai * 128 + m * 16; const float r = row_rs(rskv, row, 1.0f / 128.0f);
#pragma unroll
                for (int bj = 0; bj < 2; ++bj) {
                    const int col = u.pn * 256 + bj * 128 + wc * 32 + 8 * fq;
                    float v[8];
#pragma unroll
                    for (int n = 0; n < 2; ++n)
#pragma unroll
                        for (int e = 0; e < 4; ++e) v[n * 4 + e] = acc[ai][bj][m][n][e] * r;
                    u32x4 w; w.x = cvtpk(v[0], v[1]); w.y = cvtpk(v[2], v[3]); w.z = cvtpk(v[4], v[5]); w.w = cvtpk(v[6], v[7]);
                    *(u32x4*)(KV + ((size_t)((row >> 14) * 16 + (col >> 7)) * SEQ + (row & (SEQ - 1))) * 128 + (col & 127)) = w;
                }
                asm volatile("" ::: "memory");
            }
    }
};

#define MFMA32(a, b, c) __builtin_amdgcn_mfma_f32_32x32x16_bf16((a), (b), (c), 0, 0, 0)
constexpr int KROWB = 208, VROWB = 192, KBUFB = 64 * KROWB, VBUFB = 64 * VROWB, TBUFB = KBUFB + VBUFB;
constexpr int ATT_LDS = 2 * TBUFB;
constexpr int IMP_OFF = 53248;
constexpr int UNI_OFF = IMP_OFF + 65536;
typedef short v4i16_t __attribute__((ext_vector_type(4)));
DI s16x4 vtr(LAS const char* p) { return __builtin_bit_cast(s16x4, __builtin_amdgcn_ds_read_tr16_b64_v4i16((LAS v4i16_t*)p)); }

#define SCHED_FENCE() __builtin_amdgcn_sched_barrier(0)
template <int NCH>
DI void qk_tile(f32x16& s0, f32x16& s1, LAS const char* Ks, const bf16x8* qf, int r, int h, const f32x16& cinit) {
    LAS const char* kb = Ks + r * KROWB + h * 16;
    bf16x8 ka[NCH], kc[NCH];
#pragma unroll
    for (int c = 0; c < NCH; ++c) { ka[c] = *(LAS const bf16x8*)(kb + c * 32); kc[c] = *(LAS const bf16x8*)(kb + 32 * KROWB + c * 32); }
    SCHED_FENCE();
#pragma unroll
    for (int c = 0; c < NCH; ++c) {
        if (c == 0) { s0 = MFMA32(ka[0], qf[0], cinit); s1 = MFMA32(kc[0], qf[0], cinit); }
        else { s0 = MFMA32(ka[c], qf[c], s0); s1 = MFMA32(kc[c], qf[c], s1); }
    }
}
DI void v_frags(bf16x8 (&vf)[8], LAS const char* Vs, int lane) {
    const int h = lane >> 5, q4 = (lane & 15) >> 2, p = lane & 3, blk = (lane >> 4) & 1;
    LAS const char* vb = Vs + (4 * h + q4) * VROWB + blk * 32 + p * 8;
#pragma unroll
    for (int dt = 0; dt < 2; ++dt)
#pragma unroll
        for (int s = 0; s < 4; ++s) {
            const s16x4 lo = vtr(vb + (16 * s) * VROWB + dt * 64);
            const s16x4 hi = vtr(vb + (16 * s + 8) * VROWB + dt * 64);
            vf[dt * 4 + s] = __builtin_shufflevector(lo, hi, 0, 1, 2, 3, 4, 5, 6, 7);
        }
}
DI void pv_mma(f32x16 (&o)[2], const bf16x8 (&vf)[8], const bf16x8 (&pf)[4]) {
#pragma unroll
    for (int s = 0; s < 4; ++s) { o[0] = MFMA32(vf[s], pf[s], o[0]); o[1] = MFMA32(vf[4 + s], pf[s], o[1]); }
}
DI void pv_tile(f32x16 (&o)[2], LAS const char* Vs, const bf16x8 (&pf)[4], int lane) {
    bf16x8 vf[8]; v_frags(vf, Vs, lane); SCHED_FENCE(); pv_mma(o, vf, pf);
}
DI void mask_tile(f32x16& s0, f32x16& s1, int lo, int hi, int h) {
    const bool empty = hi < lo; const int l2 = (empty ? 100000 : lo) - 4 * h; const unsigned span = empty ? 0u : (unsigned)(hi - lo);
#pragma unroll
    for (int i = 0; i < 16; ++i) { const int c = (i & 3) + 8 * (i >> 2);
        s0[i] = ((unsigned)(c - l2) <= span) ? s0[i] : -INFINITY;
        s1[i] = ((unsigned)(c + 32 - l2) <= span) ? s1[i] : -INFINITY; }
}
#define MX3(a, b, c) __builtin_fmaxf(__builtin_fmaxf((a), (b)), (c))
DI float tile_max(const f32x16& s0, const f32x16& s1) {
    float a = MX3(s0[0], s0[1], s0[2]), b = MX3(s1[0], s1[1], s1[2]), c = MX3(s0[3], s0[4], s0[5]), d = MX3(s1[3], s1[4], s1[5]);
    a = MX3(a, s0[6], s0[7]); b = MX3(b, s1[6], s1[7]); c = MX3(c, s0[8], s0[9]); d = MX3(d, s1[8], s1[9]);
    a = MX3(a, s0[10], s0[11]); b = MX3(b, s1[10], s1[11]); c = MX3(c, s0[12], s0[13]); d = MX3(d, s1[12], s1[13]);
    a = MX3(a, s0[14], s0[15]); b = MX3(b, s1[14], s1[15]);
    return __builtin_fmaxf(__builtin_fmaxf(a, b), __builtin_fmaxf(c, d));
}
DI float tile_max_full(const f32x16& s0, const f32x16& s1) { const float a = tile_max(s0, s1); return __builtin_fmaxf(a, __shfl_xor(a, 32)); }
DI void pack_p(bf16x8 (&pf)[4], const f32x16& s0, const f32x16& s1) {
    u32x4 w;
    w.x = cvtpk(s0[0], s0[1]); w.y = cvtpk(s0[2], s0[3]); w.z = cvtpk(s0[4], s0[5]); w.w = cvtpk(s0[6], s0[7]); pf[0] = __builtin_bit_cast(bf16x8, w);
    w.x = cvtpk(s0[8], s0[9]); w.y = cvtpk(s0[10], s0[11]); w.z = cvtpk(s0[12], s0[13]); w.w = cvtpk(s0[14], s0[15]); pf[1] = __builtin_bit_cast(bf16x8, w);
    w.x = cvtpk(s1[0], s1[1]); w.y = cvtpk(s1[2], s1[3]); w.z = cvtpk(s1[4], s1[5]); w.w = cvtpk(s1[6], s1[7]); pf[2] = __builtin_bit_cast(bf16x8, w);
    w.x = cvtpk(s1[8], s1[9]); w.y = cvtpk(s1[10], s1[11]); w.z = cvtpk(s1[12], s1[13]); w.w = cvtpk(s1[14], s1[15]); pf[3] = __builtin_bit_cast(bf16x8, w);
}
constexpr float SM_THR = 8.0f;
DI void softmax_prep(f32x16& s0, f32x16& s1, float& mref, f32x16& negm, float& l, f32x16 (&o)[2]) {
    const float mxh = tile_max(s0, s1);
    const bool unset = (mref == -INFINITY);
    if (__any(unset ? (mxh > -INFINITY) : (mxh > SM_THR))) {
        const float mx = __builtin_fmaxf(mxh, __shfl_xor(mxh, 32));
        const bool need = unset ? (mx > -INFINITY) : (mx > SM_THR);
        const float delta = need ? mx : 0.f;
        mref = (unset ? 0.f : mref) + delta; mref = (unset && !need) ? -INFINITY : mref;
        const float alpha = fexp2(-delta);
#pragma unroll
        for (int i = 0; i < 16; ++i) { s0[i] -= delta; s1[i] -= delta; o[0][i] *= alpha; o[1][i] *= alpha; }
        l *= alpha;
        const float nm = (mref == -INFINITY) ? 0.f : -mref;
#pragma unroll
        for (int i = 0; i < 16; ++i) negm[i] = nm;
    }
}
DI void softmax_exp_half(f32x16& s, float& l) {
    float sa = 0.f, sb = 0.f, sc = 0.f, sd = 0.f;
    __builtin_amdgcn_s_setprio(1);
#pragma unroll
    for (int i = 0; i < 16; i += 4) { s[i] = fexp2(s[i]); s[i + 1] = fexp2(s[i + 1]); s[i + 2] = fexp2(s[i + 2]); s[i + 3] = fexp2(s[i + 3]);
        sa += s[i]; sb += s[i + 1]; sc += s[i + 2]; sd += s[i + 3]; }
    l += (sa + sb) + (sc + sd);
    __builtin_amdgcn_s_setprio(0);
}
DI void pack_half(bf16x8& p0, bf16x8& p1, const f32x16& s) {
    u32x4 w;
    w.x = cvtpk(s[0], s[1]); w.y = cvtpk(s[2], s[3]); w.z = cvtpk(s[4], s[5]); w.w = cvtpk(s[6], s[7]); p0 = __builtin_bit_cast(bf16x8, w);
    w.x = cvtpk(s[8], s[9]); w.y = cvtpk(s[10], s[11]); w.z = cvtpk(s[12], s[13]); w.w = cvtpk(s[14], s[15]); p1 = __builtin_bit_cast(bf16x8, w);
}
struct TileRegs { u32x4 k, v, k2; };
template <int DQK, class V>
DI void tile_gload(TileRegs& tr, const V& v, int tile, int tid) {
    const int row = tid >> 3, ch = tid & 7;
    tr.k = *(const GAS u32x4*)(v.krow(tile, row) + ch * 16);
    tr.v = *(const GAS u32x4*)(v.vrow(tile, row) + ch * 16);
    if constexpr (DQK == 96) { if (tid < 256) tr.k2 = *(const GAS u32x4*)(v.k2row(tile, tid >> 2) + (tid & 3) * 16); }
}
template <int DQK>
DI void tile_sstore(const TileRegs& tr, LAS char* buf, int tid) {
    const int row = tid >> 3, ch = tid & 7;
    *(LAS u32x4*)(buf + row * KROWB + ch * 16) = tr.k;
    *(LAS u32x4*)(buf + KBUFB + row * VROWB + ch * 16) = tr.v;
    if constexpr (DQK == 96) { if (tid < 256) *(LAS u32x4*)(buf + (tid >> 2) * KROWB + 128 + (tid & 3) * 16) = tr.k2; }
}
template <int DQK, class V>
DI void attn_compute(const V& v, int t, LAS char* buf, const bf16x8* qf, float& mref, f32x16& negm, float& l, f32x16 (&o)[2], int lane, int r, int h) {
    int lo, hi; v.range(t, lo, hi);
    bool excl = false;
    if constexpr (V::EXCL) excl = v.excluded(t);
    const bool any = __any(!excl && (hi >= lo) && (hi >= 0) && (lo <= 63));
    if (any) {
        f32x16 s0, s1;
        if constexpr (V::EXCL) {
            f32x16 cin;
#pragma unroll
            for (int i = 0; i < 16; ++i) cin[i] = excl ? -INFINITY : negm[i];
            qk_tile<DQK / 16>(s0, s1, buf, qf, r, h, cin);
        } else {
            qk_tile<DQK / 16>(s0, s1, buf, qf, r, h, negm);
        }
        bf16x8 vf[8]; v_frags(vf, buf + KBUFB, lane);
        SCHED_FENCE();
        if (!__all(excl || ((lo <= 0) && (hi >= 63)))) mask_tile(s0, s1, lo, hi, h);
        softmax_prep(s0, s1, mref, negm, l, o);
        bf16x8 pf[4];
        softmax_exp_half(s0, l); pack_half(pf[0], pf[1], s0);
        SCHED_FENCE();
        o[0] = MFMA32(vf[0], pf[0], o[0]); o[1] = MFMA32(vf[4], pf[0], o[1]); o[0] = MFMA32(vf[1], pf[1], o[0]); o[1] = MFMA32(vf[5], pf[1], o[1]);
        SCHED_FENCE();
        softmax_exp_half(s1, l); pack_half(pf[2], pf[3], s1);
        SCHED_FENCE();
        o[0] = MFMA32(vf[2], pf[2], o[0]); o[1] = MFMA32(vf[6], pf[2], o[1]); o[0] = MFMA32(vf[3], pf[3], o[0]); o[1] = MFMA32(vf[7], pf[3], o[1]);
    }
}
template <int DQK, class V, int MODE = 3>
DI void attn_loop(const V& v, LAS char* lds, const bf16x8* qf, float& mref, float& l, f32x16 (&o)[2]) {
    const int tid = OTID(), lane = tid & 63, r = lane & 31, h = lane >> 5;
    TileRegs Ra, Rb;
    f32x16 negm;
#pragma unroll
    for (int i = 0; i < 16; ++i) negm[i] = 0.f;
    int a0 = v.first_tile();
    if (a0 < 0) return;
    int a1 = v.next_tile(a0);
    __syncthreads();
    tile_gload<DQK>(Ra, v, a0, tid); tile_gload<DQK>(Rb, v, a1 >= 0 ? a1 : a0, tid);
    tile_sstore<DQK>(Ra, lds, tid); tile_sstore<DQK>(Rb, lds + TBUFB, tid);
    __syncthreads();
    int cur = 0;
    for (;;) {
        const int b0 = (a1 >= 0) ? v.next_tile(a1) : -1;
        const int b1 = (b0 >= 0) ? v.next_tile(b0) : -1;
        tile_gload<DQK>(Ra, v, b0 >= 0 ? b0 : a0, tid); tile_gload<DQK>(Rb, v, b1 >= 0 ? b1 : a0, tid);
        LAS char* cb_ = lds + cur * (2 * TBUFB);
        LAS char* nb_ = lds + (cur ^ 1) * (2 * TBUFB);
        attn_compute<DQK>(v, a0, cb_, qf, mref, negm, l, o, lane, r, h);
        tile_sstore<DQK>(Ra, nb_, tid);
        if (a1 >= 0) attn_compute<DQK>(v, a1, cb_ + TBUFB, qf, mref, negm, l, o, lane, r, h);
        tile_sstore<DQK>(Rb, nb_ + TBUFB, tid);
        __syncthreads();
        a0 = b0; a1 = b1; cur ^= 1;
        if (a0 < 0) break;
    }
}
template <int NCH> DI void load_q(bf16x8* qf, const bf16_t* qrow, int h) {
#pragma unroll
    for (int c = 0; c < NCH; ++c) qf[c] = *(const GAS bf16x8*)(qrow + 16 * c + 8 * h);
}
DI void store_o(bf16_t* dst, const f32x16 (&o)[2], float inv, int h) {
#pragma unroll
    for (int dt = 0; dt < 2; ++dt)
#pragma unroll
        for (int g = 0; g < 4; ++g) {
            u32x2 w; w.x = cvtpk(o[dt][4 * g] * inv, o[dt][4 * g + 1] * inv); w.y = cvtpk(o[dt][4 * g + 2] * inv, o[dt][4 * g + 3] * inv);
            *(u32x2*)(dst + 32 * dt + 8 * g + 4 * h) = w;
        }
}
DI void zero_o(f32x16 (&o)[2]) {
#pragma unroll
    for (int i = 0; i < 16; ++i) { o[0][i] = 0.f; o[1][i] = 0.f; }
}

struct MlaV {
    static constexpr bool EXCL = false;
    const char* kvb; const char* krb;
    int tq, ntile, tstart;
    DI const char* krow(int t, int row) const { return kvb + (size_t)(t * 64 + row) * 256; }
    DI const char* vrow(int t, int row) const { return kvb + (size_t)(t * 64 + row) * 256 + 128; }
    DI const char* k2row(int t, int row) const { return krb + (size_t)(t * 64 + row) * 64; }
    DI int first_tile() const { return 0; }
    DI int next_tile(int t) const { return (t + 1 < ntile) ? t + 1 : -1; }
    DI void range(int t, int& lo, int& hi) const { lo = 0; hi = tq - t * 64; }
};
template <int MODE>
DI void mla_attn_phase(LAS char* lds, const bf16_t* Q, const bf16_t* KV, const bf16_t* KR, bf16_t* AO, int bid, int G) {
    const int tid = OTID(), lane = tid & 63, w = tid >> 6, r = lane & 31, h = lane >> 5;
    int k = 0;
    for (int u = bid; u < 2048; u += G, ++k) {
        const int bh = u & 31, j = u >> 5;
        const int rnd = j >> 3, jj = j & 7;
        const int qb = 63 - (rnd * 8 + ((rnd & 1) ? (7 - jj) : jj));
        const int b = bh >> 4, hd = bh & 15;
        MlaV v; v.kvb = (const char*)(KV + (size_t)(b * 16 + hd) * SEQ * 128); v.krb = (const char*)(KR + (size_t)b * SEQ * 32);
        v.ntile = 4 * qb + 4; v.tq = qb * 256 + w * 32 + r; v.tstart = (int)(((unsigned)(u >> 5) * 5u % 8u) * (unsigned)v.ntile / 8u);
        const size_t grow = (size_t)b * SEQ + v.tq;
        bf16x8 qf[6]; load_q<6>(qf, Q + grow * 1536 + hd * 96, h);
        float m = -INFINITY, l = 0.f; f32x16 o[2]; zero_o(o);
        attn_loop<96, MlaV, MODE>(v, lds, qf, m, l, o);
        const float lt = l + __shfl_xor(l, 32); const float inv = lt > 0.f ? 1.0f / lt : 0.f;
        store_o(AO + grow * 1024 + hd * 64, o, inv, h);
    }
}
struct WinV {
    static constexpr bool EXCL = false;
    const char* kb; const char* vb; int tq, t0, t1;
    DI const char* krow(int t, int row) const { return kb + (size_t)(t * 64 + row) * 128; }
    DI const char* vrow(int t, int row) const { return vb + (size_t)(t * 64 + row) * 128; }
    DI int first_tile() const { return t0; }
    DI int next_tile(int t) const { return (t + 1 <= t1) ? t + 1 : -1; }
    DI void range(int t, int& lo, int& hi) const { lo = tq - 511 - t * 64; hi = tq - t * 64; }
};
DI void win_attn_phase(LAS char* lds, const bf16_t* P, bf16_t* OW, int bid, int G) {
    const int tid = OTID(), lane = tid & 63, w = tid >> 6, r = lane & 31, h = lane >> 5;
    for (int u = bid; u < 1024; u += G) {
        const int cb = u & 255, bg = u >> 8, b = bg >> 1, g = bg & 1;
        WinV v;
        v.kb = (const char*)(PSLOT(P, C_KW + g * 64) + (size_t)b * SEQ * 64); v.vb = (const char*)(PSLOT(P, C_VW + g * 64) + (size_t)b * SEQ * 64);
        v.t0 = cb >= 8 ? cb - 8 : 0; v.t1 = cb; v.tq = cb * 64 + w * 8 + (r >> 2);
        const int hd = g * 4 + (r & 3);
        const size_t grow = (size_t)b * SEQ + v.tq;
        bf16x8 qf[4]; load_q<4>(qf, PSLOT(P, C_QA + hd * 64) + grow * 64, h);
        float m = -INFINITY, l = 0.f; f32x16 o[2]; zero_o(o);
        attn_loop<64>(v, lds, qf, m, l, o);
        const float lt = l + __shfl_xor(l, 32); const float inv = lt > 0.f ? 1.0f / lt : 0.f;
        store_o(OW + grow * 512 + hd * 64, o, inv, h);
    }
}
struct SelV {
    static constexpr bool EXCL = true;
    const char* kb; const char* vb; int tq, cb; unsigned long long u0, u1, u2, u3, m0, m1, m2, m3;
    DI const char* krow(int t, int row) const { return kb + (size_t)(t * 64 + row) * 128; }
    DI const char* vrow(int t, int row) const { return vb + (size_t)(t * 64 + row) * 128; }
    DI unsigned long long uword(int i) const { return i == 0 ? u0 : (i == 1 ? u1 : (i == 2 ? u2 : u3)); }
    DI unsigned long long tword(int i) const { return i == 0 ? m0 : (i == 1 ? m1 : (i == 2 ? m2 : m3)); }
    DI int next_tile(int t) const { for (int j = t + 1; j <= cb; ++j) if ((uword(j >> 6) >> (j & 63)) & 1ull) return j; return -1; }
    DI int first_tile() const { return next_tile(-1); }
    DI bool excluded(int t) const { return !((tword(t >> 6) >> (t & 63)) & 1ull); }
    DI void range(int t, int& lo, int& hi) const { lo = 0; hi = tq - t * 64; }
};
DI void sel_attn_phase(LAS char* lds, const bf16_t* P, const unsigned* SELM, const bf16_t* OC, const bf16_t* OW, bf16_t* AO, int bid, int G) {
    const int tid = OTID(), lane = tid & 63, w = tid >> 6, r = lane & 31, h = lane >> 5;
    LAS unsigned* uni = (LAS unsigned*)(lds + UNI_OFF);
    for (int u = bid; u < 1024; u += G) {
        const int bg = u >> 8, cb = (bg & 1) ? 255 - (u & 255) : (u & 255), b = bg >> 1, g = bg & 1;
        SelV v;
        v.kb = (const char*)(PSLOT(P, C_KS + g * 64) + (size_t)b * SEQ * 64); v.vb = (const char*)(PSLOT(P, C_VS + g * 64) + (size_t)b * SEQ * 64);
        v.cb = cb; v.tq = cb * 64 + w * 8 + (r >> 2);
        const int hl = r & 3, hd = g * 4 + hl;
        const size_t grow = (size_t)b * SEQ + v.tq;
        {
            const u32x4* sp = (const u32x4*)(SELM + ((size_t)bg * SEQ + v.tq) * 8);
            const u32x4 a = sp[0], c = sp[1];
            v.m0 = ((unsigned long long)a.y << 32) | a.x; v.m1 = ((unsigned long long)a.w << 32) | a.z;
            v.m2 = ((unsigned long long)c.y << 32) | c.x; v.m3 = ((unsigned long long)c.w << 32) | c.z;
            __syncthreads();
            if (tid < 8) uni[tid] = 0u;
            __syncthreads();
            atomicOr((unsigned*)(uni + 0), a.x); atomicOr((unsigned*)(uni + 1), a.y); atomicOr((unsigned*)(uni + 2), a.z); atomicOr((unsigned*)(uni + 3), a.w);
            atomicOr((unsigned*)(uni + 4), c.x); atomicOr((unsigned*)(uni + 5), c.y); atomicOr((unsigned*)(uni + 6), c.z); atomicOr((unsigned*)(uni + 7), c.w);
            __syncthreads();
            v.u0 = ((unsigned long long)uni[1] << 32) | uni[0]; v.u1 = ((unsigned long long)uni[3] << 32) | uni[2];
            v.u2 = ((unsigned long long)uni[5] << 32) | uni[4]; v.u3 = ((unsigned long long)uni[7] << 32) | uni[6];
        }
        bf16x8 qf[4]; load_q<4>(qf, PSLOT(P, C_QA + hd * 64) + grow * 64, h);
        float m = -INFINITY, l = 0.f; f32x16 o[2]; zero_o(o);
        attn_loop<64>(v, lds, qf, m, l, o);
        const float lt = l + __shfl_xor(l, 32); const float inv = lt > 0.f ? 1.0f / lt : 0.f;
        const bf16_t* gp = PSLOT(P, C_GT) + grow * 32 + hd * 3;
        const float gc = bf2f(gp[0]), gs = bf2f(gp[1]) * inv, gw = bf2f(gp[2]);
        const bf16_t* ocp = OC + grow * 512 + hd * 64; const bf16_t* owp = OW + grow * 512 + hd * 64; bf16_t* dst = AO + grow * 1024 + hd * 64;
#pragma unroll
        for (int dt = 0; dt < 2; ++dt)
#pragma unroll
            for (int q4 = 0; q4 < 4; ++q4) {
                const int d = 32 * dt + 8 * q4 + 4 * h;
                const u32x2 c2 = *(const u32x2*)(ocp + d), w2 = *(const u32x2*)(owp + d);
                const float r0 = gc * bflo(c2.x) + gs * o[dt][4 * q4] + gw * bflo(w2.x);
                const float r1 = gc * bfhi(c2.x) + gs * o[dt][4 * q4 + 1] + gw * bfhi(w2.x);
                const float r2 = gc * bflo(c2.y) + gs * o[dt][4 * q4 + 2] + gw * bflo(w2.y);
                const float r3 = gc * bfhi(c2.y) + gs * o[dt][4 * q4 + 3] + gw * bfhi(w2.y);
                u32x2 ww; ww.x = cvtpk(r0, r1); ww.y = cvtpk(r2, r3);
                *(u32x2*)(dst + d) = ww;
            }
    }
}

struct CmpV {
    const char* kb; const char* vb; int imax, ntile;
    DI const char* krow(int t, int row) const { return kb + (size_t)(t * 64 + row) * 128; }
    DI const char* vrow(int t, int row) const { return vb + (size_t)(t * 64 + row) * 128; }
    DI int first_tile() const { return 0; }
    DI int next_tile(int t) const { return (t + 1 < ntile) ? t + 1 : -1; }
    DI void range(int t, int& lo, int& hi) const { lo = 0; hi = imax - t * 64; }
};
DI void cmp_attn_phase(LAS char* lds, const bf16_t* P, const bf16_t* KC, const bf16_t* VC, bf16_t* OC, unsigned* SELM, int bid, int G) {
    const int tid = OTID(), lane = tid & 63, w = tid >> 6, r = lane & 31, h = lane >> 5;
    LAS float* imp = (LAS float*)(lds + IMP_OFF);
    for (int u = bid; u < 1024; u += G) {
        const int bg = u >> 8, cb = (bg & 1) ? 255 - (u & 255) : (u & 255), b = bg >> 1, g = bg & 1;
        CmpV v; v.kb = (const char*)(KC + (size_t)bg * 1024 * 64); v.vb = (const char*)(VC + (size_t)bg * 1024 * 64);
        const int cnt = (4 * cb + 3) < 1023 ? (4 * cb + 3) : 1023; v.ntile = (cnt + 63) >> 6;
        const int tq = cb * 64 + w * 8 + (r >> 2); v.imax = (tq - 31) >> 4;
        const int hd = g * 4 + (r & 3);
        const size_t grow = (size_t)b * SEQ + tq;
        bf16x8 qf[4]; load_q<4>(qf, PSLOT(P, C_QA + hd * 64) + grow * 64, h);
        f32x16 zc;
#pragma unroll
        for (int i = 0; i < 16; ++i) zc[i] = 0.f;
        float m = -INFINITY, l = 0.f;
        TileRegs tr;
        __syncthreads();
        tile_gload<64>(tr, v, 0, tid); tile_sstore<64>(tr, lds, tid);
        __syncthreads();
        int cur = 0;
        for (int t = 0; t < v.ntile; ++t) {
            const bool more = t + 1 < v.ntile;
            if (more) tile_gload<64>(tr, v, t + 1, tid);
            LAS char* buf = lds + cur * TBUFB;
            int lo, hi; v.range(t, lo, hi);
            if (__any(hi >= 0)) {
                f32x16 s0, s1; qk_tile<4>(s0, s1, buf, qf, r, h, zc);
                if (!__all(hi >= 63)) mask_tile(s0, s1, lo, hi, h);
                const float mx = tile_max_full(s0, s1); const float mn = fmaxf(m, mx); const float mu = (mn == -INFINITY) ? 0.f : mn;
                float sum = 0.f;
#pragma unroll
                for (int i = 0; i < 16; ++i) sum += fexp2(s0[i] - mu) + fexp2(s1[i] - mu);
                l = l * fexp2(m - mu) + sum; m = mn;
            }
            if (more) tile_sstore<64>(tr, lds + (cur ^ 1) * TBUFB, tid);
            __syncthreads();
            cur ^= 1;
        }
        const float lt = l + __shfl_xor(l, 32); const float inv = lt > 0.f ? 1.0f / lt : 0.f;
        const float mu = (m == -INFINITY) ? 0.f : m;
        f32x16 o[2]; zero_o(o);
        float carry = 0.f;
        tile_gload<64>(tr, v, 0, tid); tile_sstore<64>(tr, lds, tid);
        __syncthreads();
        cur = 0;
        for (int t = 0; t < v.ntile; ++t) {
            const bool more = t + 1 < v.ntile;
            if (more) tile_gload<64>(tr, v, t + 1, tid);
            LAS char* buf = lds + cur * TBUFB;
            int lo, hi; v.range(t, lo, hi);
            if (__any(hi >= 0)) {
                f32x16 s0, s1; qk_tile<4>(s0, s1, buf, qf, r, h, zc);
                if (!__all(hi >= 63)) mask_tile(s0, s1, lo, hi, h);
#pragma unroll
                for (int i = 0; i < 16; ++i) { s0[i] = fexp2(s0[i] - mu) * inv; s1[i] = fexp2(s1[i] - mu) * inv; }
                bf16x8 pf[4]; pack_p(pf, s0, s1);
                pv_tile(o, buf + KBUFB, pf, lane);
                float av[2][4], rc[2][4];
#pragma unroll
                for (int g4 = 0; g4 < 4; ++g4) {
                    av[0][g4] = 2.f * (s0[4 * g4] + s0[4 * g4 + 1] + s0[4 * g4 + 2]) + s0[4 * g4 + 3];
                    av[1][g4] = 2.f * (s1[4 * g4] + s1[4 * g4 + 1] + s1[4 * g4 + 2]) + s1[4 * g4 + 3];
                    rc[0][g4] = __shfl_xor(s0[4 * g4 + 3], 32); rc[1][g4] = __shfl_xor(s1[4 * g4 + 3], 32);
                }
#pragma unroll
                for (int sub = 0; sub < 2; ++sub)
#pragma unroll
                    for (int g4 = 0; g4 < 4; ++g4) {
                        const float prevh0 = (g4 >= 1) ? rc[sub][g4 - 1] : ((sub == 1) ? rc[0][3] : carry);
                        float val = av[sub][g4] + (h ? rc[sub][g4] : prevh0);
                        val += __shfl_xor(val, 1); val += __shfl_xor(val, 2);
                        if ((r & 3) == 0) imp[(w * 8 + (r >> 2)) * 256 + t * 16 + sub * 8 + g4 * 2 + h] = val;
                    }
                carry = rc[1][3];
            }
            if (more) tile_sstore<64>(tr, lds + (cur ^ 1) * TBUFB, tid);
            __syncthreads();
            cur ^= 1;
        }
        store_o(OC + grow * 512 + hd * 64, o, 1.0f, h);
        __syncthreads();
        const int nfree = 16 - (cb == 0 ? 1 : (cb == 1 ? 2 : 3));
        for (int tk = 0; tk < 8; ++tk) {
            const int tl = w * 8 + tk;
            unsigned vb[4]; bool cand[4], sel[4];
#pragma unroll
            for (int s = 0; s < 4; ++s) { const int j = lane + 64 * s;
                cand[s] = (j >= 1) && (j <= cb - 2);
                vb[s] = cand[s] ? __float_as_uint(imp[tl * 256 + j]) : 0u;
                sel[s] = (j == 0) || (j == cb) || (j == cb - 1); }
            unsigned thr = 0u;
            for (int bit = 30; bit >= 0; --bit) {
                const unsigned trial = thr | (1u << bit);
                int cnt = 0;
#pragma unroll
                for (int s = 0; s < 4; ++s) cnt += __popcll(__ballot(cand[s] && vb[s] >= trial));
                thr = (cnt >= nfree) ? trial : thr;
                if (cnt == nfree) break;
            }
            int cgt = 0;
#pragma unroll
            for (int s = 0; s < 4; ++s) cgt += __popcll(__ballot(cand[s] && vb[s] > thr));
            int need = nfree - cgt, pre = 0;
            const unsigned long long ltmask = (1ull << lane) - 1ull;
#pragma unroll
            for (int s = 0; s < 4; ++s) {
                const bool eq = cand[s] && (vb[s] == thr);
                const unsigned long long bm = __ballot(eq);
                const int rank = pre + __popcll(bm & ltmask);
                sel[s] = sel[s] || (cand[s] && vb[s] > thr) || (eq && rank < need);
                pre += __popcll(bm);
            }
            unsigned long long bmo[4];
#pragma unroll
            for (int s = 0; s < 4; ++s) bmo[s] = __ballot(sel[s]);
            if (lane == 0) {
                u32x4* dp = (u32x4*)(SELM + ((size_t)bg * SEQ + cb * 64 + tl) * 8);
                u32x4 a, c; a.x = (unsigned)bmo[0]; a.y = (unsigned)(bmo[0] >> 32); a.z = (unsigned)bmo[1]; a.w = (unsigned)(bmo[1] >> 32);
                c.x = (unsigned)bmo[2]; c.y = (unsigned)(bmo[2] >> 32); c.z = (unsigned)bmo[3]; c.w = (unsigned)(bmo[3] >> 32);
                dp[0] = a; dp[1] = c;
            }
        }
    }
}
struct DilV {
    static constexpr bool EXCL = false;
    const char* kb; const char* vb; size_t rstride; int pq, t0, t1;
    DI const char* krow(int t, int row) const { return kb + (size_t)(t * 64 + row) * rstride; }
    DI const char* vrow(int t, int row) const { return vb + (size_t)(t * 64 + row) * rstride; }
    DI int first_tile() const { return t0; }
    DI int next_tile(int t) const { return (t + 1 <= t1) ? t + 1 : -1; }
    DI void range(int t, int& lo, int& hi) const { lo = pq - 128 - t * 64; hi = pq - t * 64; }
};
DI void dil_attn_phase(LAS char* lds, const bf16_t* P, bf16_t* DO, float* LSE, bf16_t* AO, int br, int bid, int G) {
    const int tid = OTID(), lane = tid & 63, w = tid >> 6, r = lane & 31, h = lane >> 5;
    const int sh = 2 * br, dil = 1 << sh;
    for (int u = bid; u < 1024; u += G) {
        const int x = u & 63, bh = u >> 6, b = bh >> 3, hd = bh & 7;
        const int res = x & (dil - 1), blk = x >> sh;
        const int P0 = blk * 256;
        DilV v;
        v.kb = (const char*)(PSLOT(P, C_KB + hd * 64) + ((size_t)b * SEQ + res) * 64); v.vb = (const char*)(PSLOT(P, C_VB + hd * 64) + ((size_t)b * SEQ + res) * 64);
        v.rstride = (size_t)128 * dil;
        v.pq = P0 + w * 32 + r; v.t0 = blk * 4 >= 2 ? blk * 4 - 2 : 0; v.t1 = blk * 4 + 3;
        const int tq = v.pq * dil + res;
        const size_t grow = (size_t)b * SEQ + tq;
        bf16x8 qf[4]; load_q<4>(qf, PSLOT(P, C_QB + hd * 64) + grow * 64, h);
        float m = -INFINITY, l = 0.f; f32x16 o[2]; zero_o(o);
        attn_loop<64>(v, lds, qf, m, l, o);
        const float lt = l + __shfl_xor(l, 32); const float inv = 1.0f / lt;
        const float lse = (m + __builtin_amdgcn_logf(lt)) * LN2;
        if (br < 2) {
            store_o(DO + (size_t)br * M * 512 + grow * 512 + hd * 64, o, inv, h);
            if (h == 0) LSE[(size_t)br * M * 8 + grow * 8 + hd] = lse;
        } else {
            const float l0 = LSE[grow * 8 + hd], l1 = LSE[(size_t)M * 8 + grow * 8 + hd];
            const float mxl = fmaxf(lse, fmaxf(l0, l1));
            const float e0 = __expf(l0 - mxl), e1 = __expf(l1 - mxl), e2 = __expf(lse - mxl);
            const float is = 1.0f / (e0 + e1 + e2);
            const float w0 = e0 * is, w1 = e1 * is, w2 = e2 * is * inv;
            const bf16_t* p0 = DO + grow * 512 + hd * 64; const bf16_t* p1 = DO + (size_t)M * 512 + grow * 512 + hd * 64;
            bf16_t* dst = AO + grow * 1024 + 512 + hd * 64;
#pragma unroll
            for (int dt = 0; dt < 2; ++dt)
#pragma unroll
                for (int q4 = 0; q4 < 4; ++q4) {
                    const int d = 32 * dt + 8 * q4 + 4 * h;
                    const u32x2 a2 = *(const u32x2*)(p0 + d), b2 = *(const u32x2*)(p1 + d);
                    const float r0 = w0 * bflo(a2.x) + w1 * bflo(b2.x) + w2 * o[dt][4 * q4];
                    const float r1 = w0 * bfhi(a2.x) + w1 * bfhi(b2.x) + w2 * o[dt][4 * q4 + 1];
                    const float r2 = w0 * bflo(a2.y) + w1 * bflo(b2.y) + w2 * o[dt][4 * q4 + 2];
                    const float r3 = w0 * bfhi(a2.y) + w1 * bfhi(b2.y) + w2 * o[dt][4 * q4 + 3];
                    u32x2 ww; ww.x = cvtpk(r0, r1); ww.y = cvtpk(r2, r3);
                    *(u32x2*)(dst + d) = ww;
                }
        }
    }
}

DI float wave_sum(float v) {
#pragma unroll
    for (int o = 1; o < 64; o <<= 1) v += __shfl_xor(v, o);
    return v;
}
template <int MODE> DI int rowmap(int n) {
    if (MODE == 1) return (n >> 7) * 256 + (n & 127);
    if (MODE == 2) return (n >> 7) * 256 + 128 + (n & 127);
    if (MODE == 3) return n < 1280 ? n : (n < 1304 ? (C_GT + n - 1280) : (n - 24));
    if (MODE == 4) return n + 128;
    return n;
}
template <int MODE>
DI void tr_item(const float* W, int K, int N, bf16_t* WT, const float* gamma, LAS float* scr, int item, int lane) {
    const int nblk = (N + 63) / 64, kb = item / nblk, nb = item % nblk, k0 = 64 * kb, n0 = 64 * nb;
    const int ncol = n0 + 4 * (lane & 15), kr = lane >> 4;
    const bool okc = ncol < N;
#pragma unroll
    for (int j = 0; j < 16; ++j) { const int kk = kr + 4 * j;
        f32x4 x = okc ? *(const GAS f32x4*)(W + (size_t)(k0 + kk) * N + ncol) : (f32x4){0.f, 0.f, 0.f, 0.f};
        if (gamma) x = x * gamma[k0 + kk];
        *(LAS f32x4*)(scr + kk * 68 + 4 * (lane & 15)) = x; }
    asm volatile("s_waitcnt lgkmcnt(0)" ::: "memory");
    const int c = lane & 7;
#pragma unroll
    for (int j = 0; j < 8; ++j) { const int n = (lane >> 3) + 8 * j; const LAS float* s = scr + (8 * c) * 68 + n;
        u32x4 o; o.x = cvtpk(s[0 * 68], s[1 * 68]); o.y = cvtpk(s[2 * 68], s[3 * 68]); o.z = cvtpk(s[4 * 68], s[5 * 68]); o.w = cvtpk(s[6 * 68], s[7 * 68]);
        if (n0 + n < N) *(u32x4*)(WT + (size_t)rowmap<MODE>(n0 + n) * K + k0 + 8 * c) = o; }
    asm volatile("s_waitcnt lgkmcnt(0)" ::: "memory");
}
#define TR_JOB(MODE, Wp, Kk, Nn, WTp, gam) do { const int nit_ = ((Kk) / 64) * (((Nn) + 63) / 64); \
    int first_ = gwi - (tr_base % NGW); if (first_ < 0) first_ += NGW; tr_base += nit_; \
    for (int it_ = first_; it_ < nit_; it_ += NGW) tr_item<MODE>((Wp), (Kk), (Nn), (WTp), (gam), scr, it_, lane); } while (0)

#define XB_TMO      128
#define XB_XCNT(j)  (256  + 64 * (j))
#define XB_XSUB(j)  (1280 + 64 * (j))
#define XB_XGEN(j)  (2304 + 64 * (j))
#define XB_TOP      3328
#define XB_TOPGEN   3392
#define XCD_BAR_WORDS 3456
#define XB_SPIN_CAP (1u << 22)
DI unsigned xb_ld(unsigned* p)              { return __hip_atomic_load(p, __ATOMIC_RELAXED, __HIP_MEMORY_SCOPE_AGENT); }
DI unsigned xb_add(unsigned* p, unsigned v) { return __hip_atomic_fetch_add(p, v, __ATOMIC_RELAXED, __HIP_MEMORY_SCOPE_AGENT); }
DI unsigned xb_xcc_id() { return (unsigned)__builtin_amdgcn_s_getreg((3 << 11) | 20) & 0xFu; }
#define XB_SPIN(cond, bar) do { unsigned _sp = 0; while (cond) { __builtin_amdgcn_s_sleep(1); \
    if ((++_sp & 255u) == 0u) { if (xb_ld(&(bar)[XB_TMO])) break; if (_sp > XB_SPIN_CAP) { atomicAdd(&(bar)[XB_TMO], 1u); break; } } } } while (0)
struct XcdBarrier { unsigned* bar; unsigned x; volatile LAS unsigned* st; };
DI XcdBarrier xcd_barrier_post(unsigned* bar, volatile LAS unsigned* st) {
    XcdBarrier b; b.bar = bar; b.x = xb_xcc_id(); b.st = st;
    if (threadIdx.x == 0) (void)xb_add(&bar[XB_XCNT(b.x)], 1u);
    return b;
}
DI void xcd_barrier_complete(unsigned* bar, unsigned x, unsigned& nloc, unsigned& nx) {
    const unsigned G = gridDim.x * gridDim.y * gridDim.z;
    unsigned sum, cnt, mine, sp = 0u;
    for (;;) {
        sum = 0u; cnt = 0u; mine = 0u;
#pragma unroll
        for (unsigned j = 0; j < 16; ++j) { const unsigned c = xb_ld(&bar[XB_XCNT(j)]); sum += c; cnt += (c > 0u) ? 1u : 0u; mine = (j == x) ? c : mine; }
        if (sum == G) break;
        __builtin_amdgcn_s_sleep(1);
        if ((++sp & 255u) == 0u) { if (xb_ld(&bar[XB_TMO])) break; if (sp > XB_SPIN_CAP) { atomicAdd(&bar[XB_TMO], 1u); break; } }
    }
    nloc = mine > 0u ? mine : 1u; nx = cnt > 0u ? cnt : 1u;
}
DI void xcd_barrier(const XcdBarrier& b) {
    asm volatile("s_waitcnt vmcnt(0)" ::: "memory");
    __syncthreads();
    if (threadIdx.x == 0) {
        unsigned* bar = b.bar;
        __builtin_amdgcn_s_waitcnt(0);
        unsigned nloc = b.st[0], nx = b.st[1];
        if (nloc == 0u) { xcd_barrier_complete(bar, b.x, nloc, nx); b.st[0] = nloc; b.st[1] = nx; }
        const unsigned old = xb_add(&bar[XB_XSUB(b.x)], 1u);
        const unsigned gen = old / nloc;
        if (old + 1u == (gen + 1u) * nloc) {
            __builtin_amdgcn_fence(__ATOMIC_RELEASE, "agent");
            asm volatile("s_waitcnt vmcnt(0)" ::: "memory");
            const unsigned og = xb_add(&bar[XB_TOP], 1u);
            const unsigned tg = og / nx;
            if (og + 1u == (tg + 1u) * nx) xb_add(&bar[XB_TOPGEN], 1u);
            else XB_SPIN(xb_ld(&bar[XB_TOPGEN]) == tg, bar);
            __builtin_amdgcn_fence(__ATOMIC_ACQUIRE, "agent");
            xb_add(&bar[XB_XGEN(b.x)], 1u);
            asm volatile("s_waitcnt vmcnt(0)" ::: "memory");
        } else {
            XB_SPIN(xb_ld(&bar[XB_XGEN(b.x)]) == gen, bar);
            __builtin_amdgcn_fence(__ATOMIC_ACQUIRE, "agent");
            asm volatile("s_waitcnt vmcnt(0)" ::: "memory");
        }
    }
    __syncthreads();
}

struct Args { const float* in[25]; float* out; unsigned char* ws; };
constexpr int LDS_BYTES = 147456;
#ifndef PHM
#define PHM 0xFFFFFF
#endif
#define PHON(b) ((PHM >> (b)) & 1)
#ifndef REP_MLA
#define REP_MLA 1
#endif
#ifndef REP_EVEN
#define REP_EVEN 1
#endif
#ifndef PROBE_MODE
#define PROBE_MODE 3
#endif
#ifndef SEL_PROBE_T
#define SEL_PROBE_T 1
#endif
#ifndef REP_EIN
#define REP_EIN 1
#endif
#ifndef REP_UQKV
#define REP_UQKV 1
#endif
#ifndef REP_SEL
#define REP_SEL 1
#endif
#ifndef REP_CMP
#define REP_CMP 1
#endif
#ifndef REP_DIL
#define REP_DIL 1
#endif
#ifndef REP_WIN
#define REP_WIN 1
#endif
#ifndef REP_PRO
#define REP_PRO 1
#endif
#ifndef REP_SYNC
#define REP_SYNC 0
#endif
#ifndef REP_FFNUP
#define REP_FFNUP 1
#endif

__global__ void __launch_bounds__(512, 2) mega_fwd(Args a) {
    extern __shared__ __attribute__((aligned(16))) unsigned char lds_raw[];
    LAS unsigned char* lds = (LAS unsigned char*)lds_raw;
    cg::grid_group grid = cg::this_grid();
    const int tid = threadIdx.x, lane = tid & 63, wave = __builtin_amdgcn_readfirstlane(tid >> 6);
    const int G = gridDim.x, bid = blockIdx.x;
    volatile LAS unsigned* bst = (volatile LAS unsigned*)(lds + LDS_BYTES - 64);
    if (tid < 2) bst[tid] = 0u;
    __syncthreads();
    const XcdBarrier xbar = xcd_barrier_post((unsigned*)a.ws + 1024, bst);
#define GSYNC() xcd_barrier(xbar)
    float* X = a.out;
#define WSB ({ unsigned char* p_ = a.ws; asm volatile("" : "+s"(p_)); p_; })
#define WGU ((bf16_t*)(WSB + WS_WGU))
#define WD ((bf16_t*)(WSB + WS_WD))
#define WEI ((bf16_t*)(WSB + WS_WEI))
#define WEO ((bf16_t*)(WSB + WS_WEO))
#define WC1 ((bf16_t*)(WSB + WS_WC1))
#define WMI ((bf16_t*)(WSB + WS_WMI))
#define WUQ ((bf16_t*)(WSB + WS_WUQ))
#define WUKV ((bf16_t*)(WSB + WS_WUKV))
#define WMO ((bf16_t*)(WSB + WS_WMO))
#define CSP ((float*)(WSB + WS_CSP))
#define CSM ((float*)(WSB + WS_CSM))
#define RS ((float*)(WSB + WS_RS))
#define XB ((bf16_t*)(WSB + WS_XB))
#define AO ((bf16_t*)(WSB + WS_AO))
#define BIG ((bf16_t*)(WSB + WS_BIG))
#define MID (WSB + WS_MID)

#pragma unroll 1
    for (int rep = 0; rep < REP_PRO; ++rep)
    if (PHON(0)) {
        LAS float* scr = (LAS float*)(lds + wave * 17408);
        const int gw = bid * 8 + wave, NGW = G * 8;
        const int gwi = wave * G + bid; int tr_base = 0;
        for (int f = 0; f < 4; ++f) {
            const int l = f >> 1, sec = f & 1;
            const float* gam = a.in[sec ? 5 : 1] + (size_t)l * 1024;
            const float* wg = a.in[sec ? 6 : 2] + (size_t)l * 1024 * 2816;
            const float* wu = a.in[sec ? 7 : 3] + (size_t)l * 1024 * 2816;
            const float* wd = a.in[sec ? 8 : 4] + (size_t)l * 1024 * 2816;
            bf16_t* wgu = WGU + (size_t)f * 5632 * 1024; bf16_t* wdt = WD + (size_t)f * 1024 * 2816;
            TR_JOB(1, wg, 1024, 2816, wgu, gam);
            TR_JOB(2, wu, 1024, 2816, wgu, gam);
            TR_JOB(0, wd, 2816, 1024, wdt, (const float*)nullptr);
        }
        TR_JOB(3, a.in[10], 1024, 2840, WEI, a.in[9]);
        TR_JOB(0, a.in[11], 1024, 1024, WEO, (const float*)nullptr);
        TR_JOB(0, a.in[14], 2048, 128, WC1, (const float*)nullptr);
        TR_JOB(4, a.in[16], 2048, 128, WC1, (const float*)nullptr);
        TR_JOB(0, a.in[18], 1024, 416, WMI, a.in[9] + 1024);
        TR_JOB(0, a.in[21], 256, 1536, WUQ, a.in[19]);
        TR_JOB(0, a.in[22], 128, 2048, WUKV, a.in[20]);
        TR_JOB(0, a.in[23], 1024, 1024, WMO, (const float*)nullptr);
        const int gt = bid * 512 + tid, NGT = G * 512;
        for (int i = gt; i < 232 * 128; i += NGT) *(u32x4*)(WEI + (size_t)2840 * 1024 + (size_t)i * 8) = (u32x4){0u, 0u, 0u, 0u};
        for (int i = gt; i < 96 * 128; i += NGT) *(u32x4*)(WMI + (size_t)416 * 1024 + (size_t)i * 8) = (u32x4){0u, 0u, 0u, 0u};
        const float l2t = 18.931568569324174f;
        for (int i = gt; i < SEQ * 8; i += NGT) { const int t = i >> 3, k = i & 7;
            const float inv = exp2f(-(float)k * 0.125f * l2t); const float ang = (float)t * inv;
            const double rev = (double)ang * 0.15915494309189535; const float fr = (float)(rev - floor(rev));
            CSP[t * 16 + k] = __builtin_amdgcn_cosf(fr); CSP[t * 16 + 8 + k] = __builtin_amdgcn_sinf(fr); }
        for (int i = gt; i < SEQ * 16; i += NGT) { const int t = i >> 4, k = i & 15;
            const float inv = exp2f(-(float)k * 0.0625f * l2t); const float ang = (float)t * inv;
            const double rev = (double)ang * 0.15915494309189535; const float fr = (float)(rev - floor(rev));
            CSM[t * 32 + k] = __builtin_amdgcn_cosf(fr); CSM[t * 32 + 16 + k] = __builtin_amdgcn_sinf(fr); }
        for (int i = gt; i < 8 * M; i += NGT) RS[M + i] = 0.f;
        const float* xin = a.in[0];
        for (int m = gw; m < M; m += NGW) {
            const f32x4* xr = (const f32x4*)(xin + (size_t)m * DM) + lane; float s = 0.f; f32x4 v[4];
#pragma unroll
            for (int j = 0; j < 4; ++j) { v[j] = xr[64 * j]; s += (v[j][0] * v[j][0] + v[j][1] * v[j][1]) + (v[j][2] * v[j][2] + v[j][3] * v[j][3]); }
            s = wave_sum(s);
            u32x2* o8 = (u32x2*)(XB + (size_t)m * DM) + lane;
#pragma unroll
            for (int j = 0; j < 4; ++j) { u32x2 w; w.x = cvtpk(v[j][0], v[j][1]); w.y = cvtpk(v[j][2], v[j][3]); o8[64 * j] = w; }
            if (lane == 0) RS[m] = s;
        }
    }
    grid.sync();

#pragma unroll 1
    for (int layer = 0; layer < 2; ++layer) {
#pragma unroll 1
        for (int half = 0; half < 2; ++half) {
            if (half == 1) {
                if (layer == 0) {
                    bf16_t* PROJ = BIG;
                    bf16_t* OC = (bf16_t*)(MID + MID_OC); bf16_t* ACMP = OC; bf16_t* OW = (bf16_t*)(MID + MID_OW);
                    float* LSE = (float*)(MID + MID_LSE); unsigned* SELM = (unsigned*)(MID + MID_SELM);
                    bf16_t* HID = (bf16_t*)(MID + MID_HID); bf16_t* KC = (bf16_t*)(MID + MID_KC); bf16_t* VC = (bf16_t*)(MID + MID_VC);
                    bf16_t* DO = XB;
                    if (PHON(1)) { pg8::Gemm g{XB, WEI, M, PROJ_W, 1024, 1024}; pg8::StaticOrder S; S.init(M, PROJ_W, G, bid);
                      EpiEvenIn E{PROJ, RS + 1 * M, CSP}; pg8::gemm_phase<EpiEvenIn, true>(lds, g, S, E); }
                    GSYNC();
#pragma unroll 1
                    for (int rep = 0; rep < REP_EVEN; ++rep) {
#pragma unroll 1
                    for (int ph = 0; ph < 3; ++ph) {
                        if (ph == 0 && !PHON(2)) {} else if (ph == 0) {
                            const int gt = bid * 512 + OTID(), NGT = G * 512;
                            for (int c = gt; c < 8192 * 256; c += NGT) {
                                const int row = c >> 8, ch = c & 255, kind = row >> 12, bg = (row >> 10) & 3, i = row & 1023, b = bg >> 1, g2 = bg & 1;
                                const int lpos = ch >> 3, d0 = (ch & 7) * 8;
                                u32x4 o = (u32x4){0u, 0u, 0u, 0u};
                                if (i < 1023) {
                                    const u32x4 s = *(const u32x4*)(PSLOT(PROJ, (kind ? C_VC : C_KC) + g2 * 64) + ((size_t)b * SEQ + 16 * i + lpos) * 64 + d0);
                                    const float* pe = a.in[kind ? 13 : 12] + lpos * 64 + d0;
                                    const f32x4 p0 = *(const f32x4*)pe, p1 = *(const f32x4*)(pe + 4);
                                    o.x = cvtpk(bflo(s.x) + p0[0], bfhi(s.x) + p0[1]); o.y = cvtpk(bflo(s.y) + p0[2], bfhi(s.y) + p0[3]);
                                    o.z = cvtpk(bflo(s.z) + p1[0], bfhi(s.z) + p1[1]); o.w = cvtpk(bflo(s.w) + p1[2], bfhi(s.w) + p1[3]);
                                }
                                *(u32x4*)(ACMP + (size_t)row * 2048 + ch * 8) = o;
                            }
                        } else if (ph == 1) {
                            if (PHON(3)) { pg8::Gemm g{ACMP, WC1, 8192, 256, 2048, 2048}; pg8::StaticOrder S; S.init(8192, 256, G, bid);
                              EpiCmp1 E{HID}; pg8::gemm_phase<EpiCmp1, false>(lds, g, S, E); }
#pragma unroll 1
                            for (int rp = 0; rp < REP_WIN; ++rp)
                            if (PHON(4)) win_attn_phase((LAS char*)lds, PROJ, OW, (G > 64) ? (bid < 32 ? 1024 : bid - 32) : bid, (G > 64) ? G - 32 : G);
                        } else {
                            const int gt = bid * 512 + OTID(), NGT = G * 512;
                            for (int c = gt; c < 8192 * 8; c += NGT) {
                                const int row = c >> 3, d0 = (c & 7) * 8, kind = row >> 12;
                                const float* w2 = a.in[kind ? 17 : 15] + d0;
                                const bf16_t* hr = HID + (size_t)row * 128;
                                float acc8[8] = {0.f, 0.f, 0.f, 0.f, 0.f, 0.f, 0.f, 0.f};
                                for (int j = 0; j < 128; j += 2) {
                                    const unsigned hv = *(const unsigned*)(hr + j);
                                    const float h0 = bflo(hv), h1 = bfhi(hv);
                                    const f32x4 wa = *(const f32x4*)(w2 + (size_t)j * 64), wb = *(const f32x4*)(w2 + (size_t)j * 64 + 4);
                                    const f32x4 wc2 = *(const f32x4*)(w2 + (size_t)(j + 1) * 64), wd2 = *(const f32x4*)(w2 + (size_t)(j + 1) * 64 + 4);
#pragma unroll
                                    for (int e = 0; e < 4; ++e) { acc8[e] += h0 * wa[e] + h1 * wc2[e]; acc8[4 + e] += h0 * wb[e] + h1 * wd2[e]; }
                                }
                                u32x4 o; o.x = cvtpk(acc8[0], acc8[1]); o.y = cvtpk(acc8[2], acc8[3]); o.z = cvtpk(acc8[4], acc8[5]); o.w = cvtpk(acc8[6], acc8[7]);
                                *(u32x4*)((kind ? VC : KC) + (size_t)(row & 4095) * 64 + d0) = o;
                            }
                        }
#pragma unroll 1
                        for (int rp = 0; rp < REP_DIL; ++rp)
                        if (PHON(5)) dil_attn_phase((LAS char*)lds, PROJ, DO, LSE, AO, ph, (ph == 1 && G > 64) ? (bid < 32 ? 1024 : bid - 32) : bid, (ph == 1 && G > 64) ? G - 32 : G);
                        GSYNC();
                    }
#pragma unroll 1
                    for (int rp = 0; rp < REP_CMP; ++rp)
                    if (PHON(6)) cmp_attn_phase((LAS char*)lds, PROJ, KC, VC, OC, SELM, bid, G);
                    GSYNC();
#pragma unroll 1
                    for (int rp = 0; rp < REP_SEL; ++rp)
                    if (PHON(7)) sel_attn_phase((LAS char*)lds, PROJ, SELM, OC, OW, AO, bid, G);
                    GSYNC();
                    }
                } else {
                    bf16_t* Q = BIG; bf16_t* KV = BIG + (size_t)M * 1536; bf16_t* C1 = (bf16_t*)MID; bf16_t* KR = (bf16_t*)(MID + 32 * MiB);
                    if (PHON(8)) { pg8::Gemm g{XB, WMI, M, 512, 1024, 1024}; pg8::StaticOrder S; S.init(M, 512, G, bid);
                      EpiMlaIn E{C1, KR, RS + 4 * M, RS + 7 * M, RS + 8 * M, CSM}; pg8::gemm_phase<EpiMlaIn, true>(lds, g, S, E); }
                    GSYNC();
                    if (PHON(9)) { pg8::Gemm g{C1, WUQ, M, 1536, 256, 512}; pg8::StaticOrder S; S.init(M, 1536, G, bid);
                      EpiMlaQ E{Q, RS + 7 * M, CSM}; pg8::gemm_phase<EpiMlaQ, true>(lds, g, S, E); }
                    if (PHON(10)) { pg8::Gemm g{C1 + 256, WUKV, M, 2048, 128, 512}; pg8::StaticOrder S; S.init(M, 2048, G, bid);
                      EpiMlaKV E{KV, RS + 8 * M}; pg8::gemm_phase<EpiMlaKV, true>(lds, g, S, E); }
                    GSYNC();
#pragma unroll 1
                    for (int rep = 0; rep < REP_MLA; ++rep)
                    if (PHON(11)) { if (rep + 1 < REP_MLA) mla_attn_phase<PROBE_MODE>((LAS char*)lds, Q, KV, KR, AO, bid, G); else mla_attn_phase<3>((LAS char*)lds, Q, KV, KR, AO, bid, G); }
                    GSYNC();
                }
                if (PHON(12)) { pg8::Gemm g{AO, layer == 0 ? WEO : WMO, M, 1024, 1024, 1024}; pg8::StaticOrder S; S.init(M, 1024, G, bid);
                  EpiResid E{X, X, XB, RS + (size_t)(layer * 3 + 2) * M, 1.0f}; pg8::gemm_phase<EpiResid, true>(lds, g, S, E); }
                GSYNC();
            }
            const int f = layer * 2 + half;
            const int rs_in = layer * 3 + half * 2, rs_out = rs_in + 1;
#pragma unroll 1
            for (int rep = 0; rep < REP_FFNUP; ++rep)
            if (PHON(13)) { pg8::Gemm g{XB, WGU + (size_t)f * 5632 * 1024, M, 5632, 1024, 1024}; pg8::StaticOrder S; S.init(M, 5632, G, bid);
              EpiSwiglu E{BIG, RS + (size_t)rs_in * M}; pg8::gemm_phase<EpiSwiglu, true>(lds, g, S, E); }
            GSYNC();
            if (PHON(14)) { pg8::Gemm g{BIG, WD + (size_t)f * 1024 * 2816, M, 1024, 2816, 2816}; pg8::StaticOrder S; S.init(M, 1024, G, bid);
              EpiResid E{(layer == 0 && half == 0) ? a.in[0] : X, X, (layer == 1 && half == 1) ? (bf16_t*)nullptr : XB, RS + (size_t)rs_out * M, 0.5f}; pg8::gemm_phase<EpiResid, true>(lds, g, S, E); }
            GSYNC();
        }
    }
#pragma unroll 1
    for (int rep = 0; rep < REP_SYNC; ++rep) GSYNC();
    {
        const int lane = OTID() & 63; const int gw = bid * 8 + wave, NGW = G * 8;
        const float* gf = a.in[24]; const float* rs = RS + 6 * M;
        for (int m = gw; m < M; m += NGW) {
            const float r = __builtin_amdgcn_rsqf(rs[m] * (1.0f / 1024.0f) + EPS);
            f32x4* xr = (f32x4*)(X + (size_t)m * DM) + lane; const f32x4* gr = (const f32x4*)gf + lane;
#pragma unroll
            for (int j = 0; j < 4; ++j) { const f32x4 v = xr[64 * j]; const f32x4 gg = gr[64 * j]; xr[64 * j] = v * r * gg; }
        }
    }
}

extern "C" void kernel_launch(void* const* d_in, const int* in_sizes, int n_in, void* d_out, int out_size, void* d_ws, size_t ws_size, hipStream_t stream) {
    static int grid = 0;
    if (grid == 0) {
        if (n_in != 25 || out_size != M * DM || ws_size < WS_END) { fprintf(stderr, "kernel_launch: unexpected sizes n_in %d out %d ws %zu (need %zu)\n", n_in, out_size, ws_size, (size_t)WS_END); grid = -1; return; }
        int dev = 0, cus = 0, per_cu = 0;
        hipGetDevice(&dev); hipDeviceGetAttribute(&cus, hipDeviceAttributeMultiprocessorCount, dev);
        if (hipFuncSetAttribute((const void*)mega_fwd, hipFuncAttributeMaxDynamicSharedMemorySize, LDS_BYTES) != hipSuccess) { fprintf(stderr, "kernel_launch: hipFuncSetAttribute failed\n"); grid = -1; return; }
        hipOccupancyMaxActiveBlocksPerMultiprocessor(&per_cu, (const void*)mega_fwd, 512, LDS_BYTES);
        if (per_cu < 1) { fprintf(stderr, "kernel_launch: occupancy query says %d blocks per CU\n", per_cu); per_cu = 1; }
        (void)hipGetLastError();
        grid = cus;
    }
    if (grid < 0) return;
    if (hipMemsetAsync(d_ws, 0, 65536, stream) != hipSuccess) { fprintf(stderr, "kernel_launch: memset of the barrier words failed\n"); return; }
    Args a{};
    for (int i = 0; i < 25; ++i) a.in[i] = (const float*)d_in[i];
    a.out = (float*)d_out; a.ws = (unsigned char*)d_ws;
    void* args[] = {&a};
    hipError_t e = hipLaunchCooperativeKernel((const void*)mega_fwd, dim3(grid), dim3(512), args, LDS_BYTES, stream);
    if (e != hipSuccess) fprintf(stderr, "cooperative launch failed: %s (grid %d)\n", hipGetErrorString(e), grid);
}
```

```cpp
#include <hip/hip_runtime.h>
#include <hip/hip_cooperative_groups.h>
#include <cstdio>
#include <cstdint>
namespace cg = cooperative_groups;

#define DI __device__ __forceinline__
#define LAS __attribute__((address_space(3)))
#define GAS __attribute__((address_space(1)))
#define OTID() ({ int t_ = threadIdx.x; asm volatile("" : "+v"(t_)); t_; })
typedef unsigned short bf16_t;
typedef short bf16x8 __attribute__((ext_vector_type(8)));
typedef short s16x4 __attribute__((ext_vector_type(4)));
typedef float f32x4 __attribute__((ext_vector_type(4)));
typedef float f32x2 __attribute__((ext_vector_type(2)));
typedef float f32x16 __attribute__((ext_vector_type(16)));
typedef unsigned u32x4 __attribute__((ext_vector_type(4)));
typedef unsigned u32x2 __attribute__((ext_vector_type(2)));
typedef __bf16 bf16x2_t __attribute__((ext_vector_type(2)));

DI unsigned cvtpk(float lo, float hi) { f32x2 v = {lo, hi}; bf16x2_t b = __builtin_convertvector(v, bf16x2_t); return __builtin_bit_cast(unsigned, b); }
DI float bf2f(unsigned short u) { return __uint_as_float(((unsigned)u) << 16); }
DI float bflo(unsigned u) { return __uint_as_float(u << 16); }
DI float bfhi(unsigned u) { return __uint_as_float(u & 0xffff0000u); }
DI float fexp2(float x) { return __builtin_amdgcn_exp2f(x); }
DI float frcp(float x) { return __builtin_amdgcn_rcpf(x); }
DI float silu_f(float x) { return x * frcp(1.0f + fexp2(-1.4426950408889634f * x)); }
DI float sigmoid_f(float x) { return frcp(1.0f + fexp2(-1.4426950408889634f * x)); }

constexpr int SEQ = 16384, NB = 2, M = NB * SEQ, DM = 1024, DFF = 2816;
constexpr float EPS = 1e-6f;
constexpr float LOG2E = 1.4426950408889634f, LN2 = 0.6931471805599453f;
constexpr int PROJ_W = 3072;
#define PSLOT(P, col) ((P) + (size_t)((col) >> 6) * M * 64)
constexpr int C_QA = 0, C_KC = 512, C_VC = 640, C_KS = 768, C_VS = 896, C_KW = 1024, C_VW = 1152, C_QB = 1280, C_KB = 1792, C_VB = 2304, C_GT = 2816;

constexpr size_t MiB = 1u << 20;
constexpr size_t SZ_WGU = (size_t)5632 * 1024 * 2, SZ_WD = (size_t)1024 * 2816 * 2;
constexpr size_t WS_WGU = 1 * MiB;
constexpr size_t WS_WD = WS_WGU + 4 * SZ_WGU;
constexpr size_t WS_WEI = WS_WD + 4 * SZ_WD;
constexpr size_t WS_WEO = WS_WEI + (size_t)3072 * 1024 * 2;
constexpr size_t WS_WC1 = WS_WEO + (size_t)1024 * 1024 * 2;
constexpr size_t WS_WMI = WS_WC1 + (size_t)256 * 2048 * 2;
constexpr size_t WS_WUQ = WS_WMI + (size_t)512 * 1024 * 2;
constexpr size_t WS_WUKV = WS_WUQ + (size_t)1536 * 256 * 2;
constexpr size_t WS_WMO = WS_WUKV + (size_t)2048 * 128 * 2;
constexpr size_t WS_CSP = WS_WMO + (size_t)1024 * 1024 * 2;
constexpr size_t WS_CSM = WS_CSP + (size_t)SEQ * 16 * 4;
constexpr size_t WS_RS = WS_CSM + (size_t)SEQ * 32 * 4;
constexpr size_t WS_XB = ((WS_RS + (size_t)9 * M * 4 + MiB - 1) / MiB) * MiB;
constexpr size_t WS_AO = WS_XB + (size_t)M * 1024 * 2;
constexpr size_t WS_BIG = WS_AO + (size_t)M * 1024 * 2;
constexpr size_t WS_MID = WS_BIG + 224 * MiB;
constexpr size_t WS_END = WS_MID + 72 * MiB;
constexpr size_t MID_OC = 0, MID_OW = 32 * MiB, MID_LSE = 64 * MiB, MID_SELM = 66 * MiB, MID_HID = 68 * MiB, MID_KC = 70 * MiB, MID_VC = 70 * MiB + 512 * 1024;

namespace pg8 {
constexpr int BM = 256, BK = 64, HALF = 128, HTB = HALF * BK * 2, STAGE_BYTES = 8 * HTB, NXCD = 8, WGM = 8;
DI int lds_byte(int r, int c) { const int st = (r >> 4) * 2 + (c >> 5), rr = r & 15, cc = c & 31, ob = rr * 64 + cc * 2; return st * 1024 + (ob ^ (((ob >> 9) & 1) << 5)); }
DI void stage_rc(int b, int& R, int& C) { const int st = b / 1024, sb = b % 1024, swz = sb ^ (((sb >> 9) & 1) << 5); R = (st >> 1) * 16 + swz / 64; C = (st & 1) * 32 + (swz % 64) / 2; }
DI int perm32(int rho) { const int n = rho >> 4, i = rho & 15; return 8 * (i >> 2) + 4 * n + (i & 3); }
struct Unit { int pm, pn; };
struct Gemm { const bf16_t* A; const bf16_t* Bt; int M, N, K, lda; };
struct StaticOrder {
    int nM, nN, nwg, G, c;
    DI void init(int M_, int N_, int G_, int c_) { nM = M_ / BM; nN = N_ / BM; nwg = nM * nN; G = G_; c = c_; }
    DI bool next(int i, Unit& u) const {
        const long L = (long)i * G + c; if (L >= nwg) return false;
        int wgid = (int)L; { const int q = nwg / NXCD, r = nwg % NXCD, xcd = wgid % NXCD, off = wgid / NXCD; wgid = (xcd < r ? xcd * (q + 1) : r * (q + 1) + (xcd - r) * q) + off; }
        const int nig = WGM * nN, gid = wgid / nig, fm = gid * WGM, gsz = (nM - fm) < WGM ? (nM - fm) : WGM;
        u.pm = fm + ((wgid % nig) % gsz); u.pn = (wgid % nig) / gsz; return true;
    }
};
template <class Epi, bool ALIGN_EPI>
DI void gemm_phase(LAS unsigned char* lds, const Gemm g, const StaticOrder& S, const Epi& E) {
    int tid_ = threadIdx.x; asm volatile("" : "+v"(tid_));
    const int tid = tid_, wid = __builtin_amdgcn_readfirstlane(tid >> 6), lane = tid & 63, wr = wid >> 2, wc = wid & 3, fr = lane & 15, fq = lane >> 4;
    int K_ = g.K, lda_ = g.lda; asm volatile("" : "+s"(K_), "+s"(lda_));
    const int K = K_, nt = K / BK, lda = lda_;
    unsigned voffA[2], voffB[2];
#pragma unroll
    for (int i = 0; i < 2; ++i) { int R, C; stage_rc(tid * 16 + i * 8192, R, C); const int Rb = Epi::PERM ? ((R & ~31) + perm32(R & 31)) : R;
        voffA[i] = (unsigned)(R * lda + C) * 2u; voffB[i] = (unsigned)(Rb * K + C) * 2u; }
    const size_t kstep = (size_t)(BK * 2);
    const size_t hstepA = (size_t)HALF * lda * 2, hstepB = (size_t)HALF * K * 2;
    const size_t tstepA = 2 * hstepA, tstepB = 2 * hstepB;
    const unsigned ldsw = (unsigned)wid * 1024u;
    const int aoff = lds_byte(wr * 64 + fr, fq * 8), boff = lds_byte(wc * 32 + fr, fq * 8);
#define PG8_SA(b, h) (((b) * 2 + (h)) * HTB)
#define PG8_SB(b, h) ((4 + (b) * 2 + (h)) * HTB)
#define PG8_STAGE(bufoff, gbase, voff) do { _Pragma("unroll") for (int _i = 0; _i < 2; ++_i) \
        __builtin_amdgcn_global_load_lds((const unsigned*)((const char*)(gbase) + (voff)[_i]), (LAS unsigned*)(lds + (bufoff) + ldsw + _i * 8192), 16, 0, 0); } while (0)
#define PG8_LDA(dst, b, h) do { _Pragma("unroll") for (int m = 0; m < 4; ++m) _Pragma("unroll") for (int k = 0; k < 2; ++k) dst[m][k] = *(const LAS bf16x8*)(lds + PG8_SA(b, h) + aoff + m * 2048 + k * 1024); } while (0)
#define PG8_LDB(dst, b, h) do { _Pragma("unroll") for (int n = 0; n < 2; ++n) _Pragma("unroll") for (int k = 0; k < 2; ++k) dst[n][k] = *(const LAS bf16x8*)(lds + PG8_SB(b, h) + boff + n * 2048 + k * 1024); } while (0)
#define PG8_MMA(ai, bj, At, Bt) do { __builtin_amdgcn_s_setprio(1); _Pragma("unroll") for (int m = 0; m < 4; ++m) _Pragma("unroll") for (int n = 0; n < 2; ++n) _Pragma("unroll") for (int k = 0; k < 2; ++k) \
        acc[ai][bj][m][n] = __builtin_amdgcn_mfma_f32_16x16x32_bf16(Bt[n][k], At[m][k], acc[ai][bj][m][n], 0, 0, 0); __builtin_amdgcn_s_setprio(0); } while (0)
#define PG8_WAIT_V(n) asm volatile("s_waitcnt vmcnt(" #n ")" ::: "memory")
#define PG8_WAIT_L(n) asm volatile("s_waitcnt lgkmcnt(" #n ")" ::: "memory")
#define PG8_BAR __builtin_amdgcn_s_barrier()
#define PG8_SCHED __builtin_amdgcn_sched_barrier(0)
    Unit cur, nxt; int ui = 0;
    if (!S.next(0, cur)) return;
    f32x4 acc[2][2][4][2];
#pragma unroll
    for (int a = 0; a < 2; ++a)
#pragma unroll
        for (int b = 0; b < 2; ++b)
#pragma unroll
            for (int m = 0; m < 4; ++m)
#pragma unroll
                for (int n = 0; n < 2; ++n) acc[a][b][m][n] = (f32x4){0.f, 0.f, 0.f, 0.f};
    bf16x8 At[4][2], B0[2][2], B1[2][2];
    const char* cA = (const char*)g.A + (size_t)cur.pm * tstepA; const char* cB = (const char*)g.Bt + (size_t)cur.pn * tstepB;
    PG8_STAGE(PG8_SB(0, 0), cB, voffB); PG8_STAGE(PG8_SB(0, 1), cB + hstepB, voffB); PG8_STAGE(PG8_SA(0, 0), cA, voffA); PG8_STAGE(PG8_SA(0, 1), cA + hstepA, voffA);
    if (wr == 1) PG8_BAR;
    PG8_WAIT_V(2); PG8_BAR;
    PG8_STAGE(PG8_SB(1, 0), cB + kstep, voffB); PG8_STAGE(PG8_SA(1, 0), cA + kstep, voffA); PG8_STAGE(PG8_SB(1, 1), cB + hstepB + kstep, voffB);
    PG8_WAIT_V(6); PG8_BAR;
    for (;;) {
        const bool has_next = S.next(ui + 1, nxt);
        const char* nA = has_next ? (const char*)g.A + (size_t)nxt.pm * tstepA : cA; const char* nB = has_next ? (const char*)g.Bt + (size_t)nxt.pn * tstepB : cB;
        for (int t = 0; t < nt; t += 2) {
            const bool last = (t == nt - 2);
            const char* a1 = cA + (size_t)(t + 1) * kstep;
            const char* a2 = last ? nA : cA + (size_t)(t + 2) * kstep; const char* b2 = last ? nB : cB + (size_t)(t + 2) * kstep;
            const char* a3 = a2 + kstep; const char* b3 = b2 + kstep;
            PG8_LDB(B0, 0, 0); PG8_LDB(B1, 0, 1); PG8_SCHED; PG8_LDA(At, 0, 0); PG8_STAGE(PG8_SA(1, 1), a1 + hstepA, voffA);
            PG8_WAIT_V(8); PG8_WAIT_L(0); PG8_BAR; PG8_MMA(0, 0, At, B0); PG8_MMA(0, 1, At, B1); PG8_BAR; PG8_SCHED;
            PG8_LDA(At, 0, 1); PG8_STAGE(PG8_SB(0, 0), b2, voffB); PG8_STAGE(PG8_SB(0, 1), b2 + hstepB, voffB); PG8_STAGE(PG8_SA(0, 0), a2, voffA);
            PG8_WAIT_V(8); PG8_WAIT_L(0); PG8_BAR; PG8_MMA(1, 0, At, B0); PG8_MMA(1, 1, At, B1); PG8_BAR; PG8_SCHED;
            PG8_LDB(B0, 1, 0); PG8_LDB(B1, 1, 1); PG8_SCHED; PG8_LDA(At, 1, 0); PG8_STAGE(PG8_SA(0, 1), a2 + hstepA, voffA);
            PG8_WAIT_V(8); PG8_WAIT_L(0); PG8_BAR; PG8_MMA(0, 0, At, B0); PG8_MMA(0, 1, At, B1); PG8_BAR; PG8_SCHED;
            PG8_LDA(At, 1, 1); PG8_STAGE(PG8_SB(1, 0), b3, voffB); PG8_STAGE(PG8_SB(1, 1), b3 + hstepB, voffB); PG8_STAGE(PG8_SA(1, 0), a3, voffA);
            PG8_WAIT_V(8); PG8_WAIT_L(0); PG8_BAR; PG8_MMA(1, 0, At, B0); PG8_MMA(1, 1, At, B1); PG8_BAR; PG8_SCHED;
        }
        if constexpr (ALIGN_EPI) { if (wr == 0) PG8_BAR; }
        E(acc, cur, wr, wc, fr, fq);
        if (!has_next) break;
#pragma unroll
        for (int a = 0; a < 2; ++a)
#pragma unroll
            for (int b = 0; b < 2; ++b)
#pragma unroll
                for (int m = 0; m < 4; ++m)
#pragma unroll
                    for (int n = 0; n < 2; ++n) acc[a][b][m][n] = (f32x4){0.f, 0.f, 0.f, 0.f};
        cur = nxt; cA = nA; cB = nB; ++ui;
        if constexpr (ALIGN_EPI) { if (wr == 1) PG8_BAR; }
    }
    PG8_WAIT_V(0);
    if constexpr (!ALIGN_EPI) { if (wr == 0) PG8_BAR; }
    PG8_BAR;
#undef PG8_SA
#undef PG8_SB
#undef PG8_STAGE
#undef PG8_LDA
#undef PG8_LDB
#undef PG8_MMA
#undef PG8_WAIT_V
#undef PG8_WAIT_L
#undef PG8_BAR
#undef PG8_SCHED
}
}

typedef f32x4 AccT[2][2][4][2];
DI float row_rs(const float* rs, int row, float invn) { return __builtin_amdgcn_rsqf(rs[row] * invn + EPS); }

struct EpiSwiglu {
    static constexpr bool PERM = true;
    bf16_t* H; const float* rs;
    DI void operator()(const AccT& acc, const pg8::Unit& u, int wr, int wc, int fr, int fq) const {
        const int row0 = u.pm * 256 + wr * 64 + fr, col = u.pn * 128 + wc * 32 + 8 * fq;
        float rr[2][4];
#pragma unroll
        for (int ai = 0; ai < 2; ++ai)
#pragma unroll
            for (int m = 0; m < 4; ++m) rr[ai][m] = *(const GAS float*)(rs + row0 + ai * 128 + m * 16);
#pragma unroll
        for (int ai = 0; ai < 2; ++ai)
#pragma unroll
            for (int m = 0; m < 4; ++m) {
                const int row = row0 + ai * 128 + m * 16; const float r = __builtin_amdgcn_rsqf(rr[ai][m] * (1.0f / 1024.0f) + EPS);
                float hv[8];
#pragma unroll
                for (int n = 0; n < 2; ++n)
#pragma unroll
                    for (int e = 0; e < 4; ++e) { const float gv = acc[ai][0][m][n][e] * r, uv = acc[ai][1][m][n][e] * r; hv[n * 4 + e] = silu_f(gv) * uv; }
                u32x4 w; w.x = cvtpk(hv[0], hv[1]); w.y = cvtpk(hv[2], hv[3]); w.z = cvtpk(hv[4], hv[5]); w.w = cvtpk(hv[6], hv[7]);
                *(GAS u32x4*)(H + (size_t)row * DFF + col) = w;
            }
    }
};
struct EpiResid {
    static constexpr bool PERM = false;
    const float* base; float* out; bf16_t* xb; float* rs_out; float coef;
    DI void operator()(const AccT& acc, const pg8::Unit& u, int wr, int wc, int fr, int fq) const {
        const int row0 = u.pm * 256 + wr * 64 + fr, col0 = u.pn * 256 + wc * 32 + 4 * fq;
#pragma unroll
        for (int ai = 0; ai < 2; ++ai)
#pragma unroll
            for (int m = 0; m < 4; ++m) {
                const int row = row0 + ai * 128 + m * 16; const size_t off = (size_t)row * DM + col0; float ss = 0.f;
#pragma unroll
                for (int bj = 0; bj < 2; ++bj)
#pragma unroll
                    for (int n = 0; n < 2; ++n) {
                        const f32x4 bs = *(const f32x4*)(base + off + bj * 128 + n * 16);
                        const f32x4 v = bs + acc[ai][bj][m][n] * coef;
                        *(f32x4*)(out + off + bj * 128 + n * 16) = v;
                        if (xb) { u32x2 w; w.x = cvtpk(v[0], v[1]); w.y = cvtpk(v[2], v[3]); *(u32x2*)(xb + off + bj * 128 + n * 16) = w; }
                        ss += (v[0] * v[0] + v[1] * v[1]) + (v[2] * v[2] + v[3] * v[3]);
                    }
                ss += __shfl_xor(ss, 16); ss += __shfl_xor(ss, 32);
                if (fq == 0) atomicAdd(rs_out + row, ss);
            }
    }
};
struct EpiEvenIn {
    static constexpr bool PERM = true;
    bf16_t* P; const float* rs; const float* csp;
    DI void operator()(const AccT& acc, const pg8::Unit& u, int wr, int wc, int fr, int fq) const {
        const int row0 = u.pm * 256 + wr * 64 + fr;
#pragma unroll
        for (int bj = 0; bj < 2; ++bj) {
            const int cw = u.pn * 256 + bj * 128 + wc * 32;
            if (cw >= 2848) continue;
            const int hd = cw >> 6;
            const bool isq = (hd < 8) || (hd >= 20 && hd < 28);
            const bool rope = ((wc & 1) == 0) && (isq || hd == 8 || hd == 9 || hd == 12 || hd == 13 || hd == 16 || hd == 17 || (hd >= 28 && hd < 36));
            const bool gate = (hd == 44);
            const float qs = isq ? 0.125f * LOG2E : 1.0f;
            const int col = cw + 8 * fq;
#pragma unroll
            for (int ai = 0; ai < 2; ++ai)
#pragma unroll
                for (int m = 0; m < 4; ++m) {
                    const int row = row0 + ai * 128 + m * 16; const float r = row_rs(rs, row, 1.0f / 1024.0f) * qs;
                    float v[8];
#pragma unroll
                    for (int n = 0; n < 2; ++n)
#pragma unroll
                        for (int e = 0; e < 4; ++e) v[n * 4 + e] = acc[ai][bj][m][n][e] * r;
                    if (rope) {
                        const float* cs = csp + (size_t)(row & (SEQ - 1)) * 16;
                        const f32x4 c0 = *(const f32x4*)(cs), c1 = *(const f32x4*)(cs + 4), s0 = *(const f32x4*)(cs + 8), s1 = *(const f32x4*)(cs + 12);
                        const float cc[8] = {c0[0], c0[1], c0[2], c0[3], c1[0], c1[1], c1[2], c1[3]};
                        const float sn[8] = {s0[0], s0[1], s0[2], s0[3], s1[0], s1[1], s1[2], s1[3]};
#pragma unroll
                        for (int e = 0; e < 8; ++e) {
                            const float pv = __shfl_xor(v[e], 16);
                            const float o1 = v[e] * cc[e] - pv * sn[e], o2 = v[e] * cc[e] + pv * sn[e];
                            v[e] = (fq == 0) ? o1 : ((fq == 1) ? o2 : v[e]);
                        }
                    }
                    if (gate) {
#pragma unroll
                        for (int e = 0; e < 8; ++e) v[e] = sigmoid_f(v[e]);
                    }
                    u32x4 w; w.x = cvtpk(v[0], v[1]); w.y = cvtpk(v[2], v[3]); w.z = cvtpk(v[4], v[5]); w.w = cvtpk(v[6], v[7]);
                    if (gate) *(u32x4*)(PSLOT(P, C_GT) + (size_t)row * 32 + 8 * fq) = w;
                    else *(u32x4*)(PSLOT(P, cw) + (size_t)row * 64 + (col & 63)) = w;
                }
        }
    }
};
struct EpiCmp1 {
    static constexpr bool PERM = true;
    bf16_t* Hd;
    DI void operator()(const AccT& acc, const pg8::Unit& u, int wr, int wc, int fr, int fq) const {
        const int row0 = u.pm * 256 + wr * 64 + fr, col = wc * 32 + 8 * fq; const bool isv = u.pm >= 16;
#pragma unroll
        for (int ai = 0; ai < 2; ++ai)
#pragma unroll
            for (int m = 0; m < 4; ++m) {
                const int row = row0 + ai * 128 + m * 16; float v[8];
#pragma unroll
                for (int n = 0; n < 2; ++n)
#pragma unroll
                    for (int e = 0; e < 4; ++e) v[n * 4 + e] = silu_f(isv ? acc[ai][1][m][n][e] : acc[ai][0][m][n][e]);
                u32x4 w; w.x = cvtpk(v[0], v[1]); w.y = cvtpk(v[2], v[3]); w.z = cvtpk(v[4], v[5]); w.w = cvtpk(v[6], v[7]);
                *(u32x4*)(Hd + (size_t)row * 128 + col) = w;
            }
    }
};
struct EpiMlaIn {
    static constexpr bool PERM = true;
    bf16_t* C1; bf16_t* KR; const float* rs; float* rsq; float* rskv; const float* csm;
    DI void operator()(const AccT& acc, const pg8::Unit& u, int wr, int wc, int fr, int fq) const {
        const int row0 = u.pm * 256 + wr * 64 + fr;
#pragma unroll
        for (int ai = 0; ai < 2; ++ai)
#pragma unroll
            for (int m = 0; m < 4; ++m) {
                const int row = row0 + ai * 128 + m * 16; const float r = row_rs(rs, row, 1.0f / 1024.0f);
#pragma unroll
                for (int bj = 0; bj < 2; ++bj) {
                    const int cw = u.pn * 256 + bj * 128 + wc * 32;
                    if (cw >= 416) continue;
                    const bool rope = (cw == 384);
                    float* rsacc = (cw < 256) ? rsq : rskv;
                    const int col = cw + 8 * fq;
                    float v[8];
#pragma unroll
                    for (int n = 0; n < 2; ++n)
#pragma unroll
                        for (int e = 0; e < 4; ++e) v[n * 4 + e] = acc[ai][bj][m][n][e] * r;
                    if (rope) {
                        const float* cs = csm + (size_t)(row & (SEQ - 1)) * 32 + 8 * (fq & 1);
#pragma unroll
                        for (int hf = 0; hf < 2; ++hf) {
                            const f32x4 c0 = *(const f32x4*)(cs + 4 * hf), s0 = *(const f32x4*)(cs + 16 + 4 * hf);
#pragma unroll
                            for (int e = 0; e < 4; ++e) {
                                const float x = v[hf * 4 + e]; const float pv = __shfl_xor(x, 32);
                                v[hf * 4 + e] = (fq < 2) ? (x * c0[e] - pv * s0[e]) : (x * c0[e] + pv * s0[e]);
                            }
                        }
                    } else {
                        float ss = 0.f;
#pragma unroll
                        for (int e = 0; e < 8; ++e) ss += v[e] * v[e];
                        ss += __shfl_xor(ss, 16); ss += __shfl_xor(ss, 32);
                        if (fq == 0) atomicAdd(rsacc + row, ss);
                    }
                    u32x4 w; w.x = cvtpk(v[0], v[1]); w.y = cvtpk(v[2], v[3]); w.z = cvtpk(v[4], v[5]); w.w = cvtpk(v[6], v[7]);
                    if (rope) *(u32x4*)(KR + (size_t)row * 32 + 8 * fq) = w; else *(u32x4*)(C1 + (size_t)row * 512 + col) = w;
                }
                asm volatile("" ::: "memory");
            }
    }
};
struct EpiMlaQ {
    static constexpr bool PERM = true;
    bf16_t* Q; const float* rsq; const float* csm;
    DI void operator()(const AccT& acc, const pg8::Unit& u, int wr, int wc, int fr, int fq) const {
        const int row0 = u.pm * 256 + wr * 64 + fr;
        const float qs = 0.10206207261596575f * LOG2E;
#pragma unroll
        for (int ai = 0; ai < 2; ++ai)
#pragma unroll
            for (int m = 0; m < 4; ++m) {
                const int row = row0 + ai * 128 + m * 16; const float r = row_rs(rsq, row, 1.0f / 256.0f) * qs;
#pragma unroll
                for (int bj = 0; bj < 2; ++bj) {
                    const int cw = u.pn * 256 + bj * 128 + wc * 32;
                    const bool rope = ((cw >> 5) % 3) == 2;
                    const int col = cw + 8 * fq;
                    float v[8];
#pragma unroll
                    for (int n = 0; n < 2; ++n)
#pragma unroll
                        for (int e = 0; e < 4; ++e) v[n * 4 + e] = acc[ai][bj][m][n][e] * r;
                    if (rope) {
                        const float* cs = csm + (size_t)(row & (SEQ - 1)) * 32 + 8 * (fq & 1);
#pragma unroll
                        for (int hf = 0; hf < 2; ++hf) {
                            const f32x4 c0 = *(const f32x4*)(cs + 4 * hf), s0 = *(const f32x4*)(cs + 16 + 4 * hf);
#pragma unroll
                            for (int e = 0; e < 4; ++e) {
                                const float x = v[hf * 4 + e]; const float pv = __shfl_xor(x, 32);
                                v[hf * 4 + e] = (fq < 2) ? (x * c0[e] - pv * s0[e]) : (x * c0[e] + pv * s0[e]);
                            }
                        }
                    }
                    u32x4 w; w.x = cvtpk(v[0], v[1]); w.y = cvtpk(v[2], v[3]); w.z = cvtpk(v[4], v[5]); w.w = cvtpk(v[6], v[7]);
                    *(u32x4*)(Q + (size_t)row * 1536 + col) = w;
                }
                asm volatile("" ::: "memory");
            }
    }
};
struct EpiMlaKV {
    static constexpr bool PERM = true;
    bf16_t* KV; const float* rskv;
    DI void operator()(const AccT& acc, const pg8::Unit& u, int wr, int wc, int fr, int fq) const {
        const int row0 = u.pm * 256 + wr * 64 + fr;
#pragma unroll
        for (int ai = 0; ai < 2; ++ai)
#pragma unroll
            for (int m = 0; m < 4; ++m) {
                const int row = row0 + ai * 128 + m * 16; const float r = row_rs(rskv, row, 1.0f / 128.0f);
#pragma unroll
                for (int bj = 0; bj < 2; ++bj) {
                    const int col = u.pn * 256 + bj * 128 + wc * 32 + 8 * fq;
                    float v[8];
#pragma unroll
                    for (int n = 0; n < 2; ++n)
#pragma unroll
                        for (int e = 0; e < 4; ++e) v[n * 4 + e] = acc[ai][bj][m][n][e] * r;
                    u32x4 w; w.x = cvtpk(v[0], v[1]); w.y = cvtpk(v[2], v[3]); w.z = cvtpk(v[4], v[5]); w.w = cvtpk(v[6], v[7]);
                    *(u32x4*)(KV + ((size_t)((row >> 14) * 16 + (col >> 7)) * SEQ + (row & (SEQ - 1))) * 128 + (col & 127)) = w;
                }
                asm volatile("" ::: "memory");
            }
    }
};

#define MFMA32(a, b, c) __builtin_amdgcn_mfma_f32_32x32x16_bf16((a), (b), (c), 0, 0, 0)
constexpr int KROWB = 208, VROWB = 192, KBUFB = 64 * KROWB, VBUFB = 64 * VROWB, TBUFB = KBUFB + VBUFB;
constexpr int ATT_LDS = 2 * TBUFB;
constexpr int IMP_OFF = 53248;
constexpr int UNI_OFF = IMP_OFF + 65536;
typedef short v4i16_t __attribute__((ext_vector_type(4)));
DI s16x4 vtr(LAS const char* p) { return __builtin_bit_cast(s16x4, __builtin_amdgcn_ds_read_tr16_b64_v4i16((LAS v4i16_t*)p)); }

#define SCHED_FENCE() __builtin_amdgcn_sched_barrier(0)
template <int NCH>
DI void qk_tile(f32x16& s0, f32x16& s1, LAS const char* Ks, const bf16x8* qf, int r, int h, const f32x16& cinit) {
    LAS const char* kb = Ks + r * KROWB + h * 16;
    bf16x8 ka[NCH], kc[NCH];
#pragma unroll
    for (int c = 0; c < NCH; ++c) { ka[c] = *(LAS const bf16x8*)(kb + c * 32); kc[c] = *(LAS const bf16x8*)(kb + 32 * KROWB + c * 32); }
    SCHED_FENCE();
#pragma unroll
    for (int c = 0; c < NCH; ++c) {
        if (c == 0) { s0 = MFMA32(ka[0], qf[0], cinit); s1 = MFMA32(kc[0], qf[0], cinit); }
        else { s0 = MFMA32(ka[c], qf[c], s0); s1 = MFMA32(kc[c], qf[c], s1); }
    }
}
DI void v_frags(bf16x8 (&vf)[8], LAS const char* Vs, int lane) {
    const int h = lane >> 5, q4 = (lane & 15) >> 2, p = lane & 3, blk = (lane >> 4) & 1;
    LAS const char* vb = Vs + (4 * h + q4) * VROWB + blk * 32 + p * 8;
#pragma unroll
    for (int dt = 0; dt < 2; ++dt)
#pragma unroll
        for (int s = 0; s < 4; ++s) {
            const s16x4 lo = vtr(vb + (16 * s) * VROWB + dt * 64);
            const s16x4 hi = vtr(vb + (16 * s + 8) * VROWB + dt * 64);
            vf[dt * 4 + s] = __builtin_shufflevector(lo, hi, 0, 1, 2, 3, 4, 5, 6, 7);
        }
}
DI void pv_mma(f32x16 (&o)[2], const bf16x8 (&vf)[8], const bf16x8 (&pf)[4]) {
#pragma unroll
    for (int s = 0; s < 4; ++s) { o[0] = MFMA32(vf[s], pf[s], o[0]); o[1] = MFMA32(vf[4 + s], pf[s], o[1]); }
}
DI void pv_tile(f32x16 (&o)[2], LAS const char* Vs, const bf16x8 (&pf)[4], int lane) {
    bf16x8 vf[8]; v_frags(vf, Vs, lane); SCHED_FENCE(); pv_mma(o, vf, pf);
}
DI void mask_tile(f32x16& s0, f32x16& s1, int lo, int hi, int h) {
    const bool empty = hi < lo; const int l2 = (empty ? 100000 : lo) - 4 * h; const unsigned span = empty ? 0u : (unsigned)(hi - lo);
#pragma unroll
    for (int i = 0; i < 16; ++i) { const int c = (i & 3) + 8 * (i >> 2);
        s0[i] = ((unsigned)(c - l2) <= span) ? s0[i] : -INFINITY;
        s1[i] = ((unsigned)(c + 32 - l2) <= span) ? s1[i] : -INFINITY; }
}
#define MX3(a, b, c) __builtin_fmaxf(__builtin_fmaxf((a), (b)), (c))
DI float tile_max(const f32x16& s0, const f32x16& s1) {
    float a = MX3(s0[0], s0[1], s0[2]), b = MX3(s1[0], s1[1], s1[2]), c = MX3(s0[3], s0[4], s0[5]), d = MX3(s1[3], s1[4], s1[5]);
    a = MX3(a, s0[6], s0[7]); b = MX3(b, s1[6], s1[7]); c = MX3(c, s0[8], s0[9]); d = MX3(d, s1[8], s1[9]);
    a = MX3(a, s0[10], s0[11]); b = MX3(b, s1[10], s1[11]); c = MX3(c, s0[12], s0[13]); d = MX3(d, s1[12], s1[13]);
    a = MX3(a, s0[14], s0[15]); b = MX3(b, s1[14], s1[15]);
    return __builtin_fmaxf(__builtin_fmaxf(a, b), __builtin_fmaxf(c, d));
}
DI float tile_max_full(const f32x16& s0, const f32x16& s1) { const float a = tile_max(s0, s1); return __builtin_fmaxf(a, __shfl_xor(a, 32)); }
DI void pack_p(bf16x8 (&pf)[4], const f32x16& s0, const f32x16& s1) {
    u32x4 w;
    w.x = cvtpk(s0[0], s0[1]); w.y = cvtpk(s0[2], s0[3]); w.z = cvtpk(s0[4], s0[5]); w.w = cvtpk(s0[6], s0[7]); pf[0] = __builtin_bit_cast(bf16x8, w);
    w.x = cvtpk(s0[8], s0[9]); w.y = cvtpk(s0[10], s0[11]); w.z = cvtpk(s0[12], s0[13]); w.w = cvtpk(s0[14], s0[15]); pf[1] = __builtin_bit_cast(bf16x8, w);
    w.x = cvtpk(s1[0], s1[1]); w.y = cvtpk(s1[2], s1[3]); w.z = cvtpk(s1[4], s1[5]); w.w = cvtpk(s1[6], s1[7]); pf[2] = __builtin_bit_cast(bf16x8, w);
    w.x = cvtpk(s1[8], s1[9]); w.y = cvtpk(s1[10], s1[11]); w.z = cvtpk(s1[12], s1[13]); w.w = cvtpk(s1[14], s1[15]); pf[3] = __builtin_bit_cast(bf16x8, w);
}
constexpr float SM_THR = 8.0f;
DI void softmax_prep(f32x16& s0, f32x16& s1, float& mref, f32x16& negm, float& l, f32x16 (&o)[2]) {
    const float mxh = tile_max(s0, s1);
    const bool unset = (mref == -INFINITY);
    if (__any(unset ? (mxh > -INFINITY) : (mxh > SM_THR))) {
        const float mx = __builtin_fmaxf(mxh, __shfl_xor(mxh, 32));
        const bool need = unset ? (mx > -INFINITY) : (mx > SM_THR);
        const float delta = need ? mx : 0.f;
        mref = (unset ? 0.f : mref) + delta; mref = (unset && !need) ? -INFINITY : mref;
        const float alpha = fexp2(-delta);
#pragma unroll
        for (int i = 0; i < 16; ++i) { s0[i] -= delta; s1[i] -= delta; o[0][i] *= alpha; o[1][i] *= alpha; }
        l *= alpha;
        const float nm = (mref == -INFINITY) ? 0.f : -mref;
#pragma unroll
        for (int i = 0; i < 16; ++i) negm[i] = nm;
    }
}
DI void softmax_exp_half(f32x16& s, float& l) {
    float sa = 0.f, sb = 0.f, sc = 0.f, sd = 0.f;
#pragma unroll
    for (int i = 0; i < 16; i += 4) { s[i] = fexp2(s[i]); s[i + 1] = fexp2(s[i + 1]); s[i + 2] = fexp2(s[i + 2]); s[i + 3] = fexp2(s[i + 3]);
        sa += s[i]; sb += s[i + 1]; sc += s[i + 2]; sd += s[i + 3]; }
    l += (sa + sb) + (sc + sd);
}
DI void pack_half(bf16x8& p0, bf16x8& p1, const f32x16& s) {
    u32x4 w;
    w.x = cvtpk(s[0], s[1]); w.y = cvtpk(s[2], s[3]); w.z = cvtpk(s[4], s[5]); w.w = cvtpk(s[6], s[7]); p0 = __builtin_bit_cast(bf16x8, w);
    w.x = cvtpk(s[8], s[9]); w.y = cvtpk(s[10], s[11]); w.z = cvtpk(s[12], s[13]); w.w = cvtpk(s[14], s[15]); p1 = __builtin_bit_cast(bf16x8, w);
}
struct TileRegs { u32x4 k, v, k2; };
template <int DQK, class V>
DI void tile_gload(TileRegs& tr, const V& v, int tile, int tid) {
    const int row = tid >> 3, ch = tid & 7;
    tr.k = *(const GAS u32x4*)(v.krow(tile, row) + ch * 16);
    tr.v = *(const GAS u32x4*)(v.vrow(tile, row) + ch * 16);
    if constexpr (DQK == 96) { if (tid < 256) tr.k2 = *(const GAS u32x4*)(v.k2row(tile, tid >> 2) + (tid & 3) * 16); }
}
template <int DQK>
DI void tile_sstore(const TileRegs& tr, LAS char* buf, int tid) {
    const int row = tid >> 3, ch = tid & 7;
    *(LAS u32x4*)(buf + row * KROWB + ch * 16) = tr.k;
    *(LAS u32x4*)(buf + KBUFB + row * VROWB + ch * 16) = tr.v;
    if constexpr (DQK == 96) { if (tid < 256) *(LAS u32x4*)(buf + (tid >> 2) * KROWB + 128 + (tid & 3) * 16) = tr.k2; }
}
template <int DQK, class V>
DI void attn_compute(const V& v, int t, LAS char* buf, const bf16x8* qf, float& mref, f32x16& negm, float& l, f32x16 (&o)[2], int lane, int r, int h) {
    int lo, hi; v.range(t, lo, hi);
    bool excl = false;
    if constexpr (V::EXCL) excl = v.excluded(t);
    const bool any = __any(!excl && (hi >= lo) && (hi >= 0) && (lo <= 63));
    if (any) {
        f32x16 s0, s1;
        if constexpr (V::EXCL) {
            f32x16 cin;
#pragma unroll
            for (int i = 0; i < 16; ++i) cin[i] = excl ? -INFINITY : negm[i];
            qk_tile<DQK / 16>(s0, s1, buf, qf, r, h, cin);
        } else {
            qk_tile<DQK / 16>(s0, s1, buf, qf, r, h, negm);
        }
        bf16x8 vf[8]; v_frags(vf, buf + KBUFB, lane);
        SCHED_FENCE();
        __builtin_amdgcn_s_setprio(1);
        if (!__all(excl || ((lo <= 0) && (hi >= 63)))) mask_tile(s0, s1, lo, hi, h);
        softmax_prep(s0, s1, mref, negm, l, o);
        bf16x8 pf[4];
        softmax_exp_half(s0, l); pack_half(pf[0], pf[1], s0);
        __builtin_amdgcn_s_setprio(0);
        SCHED_FENCE();
        o[0] = MFMA32(vf[0], pf[0], o[0]); o[1] = MFMA32(vf[4], pf[0], o[1]); o[0] = MFMA32(vf[1], pf[1], o[0]); o[1] = MFMA32(vf[5], pf[1], o[1]);
        SCHED_FENCE();
        __builtin_amdgcn_s_setprio(1);
        softmax_exp_half(s1, l); pack_half(pf[2], pf[3], s1);
        __builtin_amdgcn_s_setprio(0);
        SCHED_FENCE();
        o[0] = MFMA32(vf[2], pf[2], o[0]); o[1] = MFMA32(vf[6], pf[2], o[1]); o[0] = MFMA32(vf[3], pf[3], o[0]); o[1] = MFMA32(vf[7], pf[3], o[1]);
    }
}
template <int DQK, class V, int MODE = 3>
DI void attn_loop(const V& v, LAS char* lds, const bf16x8* qf, float& mref, float& l, f32x16 (&o)[2]) {
    const int tid = OTID(), lane = tid & 63, r = lane & 31, h = lane >> 5;
    TileRegs Ra, Rb;
    f32x16 negm;
#pragma unroll
    for (int i = 0; i < 16; ++i) negm[i] = 0.f;
    int a0 = v.first_tile();
    if (a0 < 0) return;
    int a1 = v.next_tile(a0);
    __syncthreads();
    tile_gload<DQK>(Ra, v, a0, tid); tile_gload<DQK>(Rb, v, a1 >= 0 ? a1 : a0, tid);
    tile_sstore<DQK>(Ra, lds, tid); tile_sstore<DQK>(Rb, lds + TBUFB, tid);
    __syncthreads();
    int cur = 0;
    for (;;) {
        const int b0 = (a1 >= 0) ? v.next_tile(a1) : -1;
        const int b1 = (b0 >= 0) ? v.next_tile(b0) : -1;
        tile_gload<DQK>(Ra, v, b0 >= 0 ? b0 : a0, tid); tile_gload<DQK>(Rb, v, b1 >= 0 ? b1 : a0, tid);
        LAS char* cb_ = lds + cur * (2 * TBUFB);
        LAS char* nb_ = lds + (cur ^ 1) * (2 * TBUFB);
        attn_compute<DQK>(v, a0, cb_, qf, mref, negm, l, o, lane, r, h);
        tile_sstore<DQK>(Ra, nb_, tid);
        if (a1 >= 0) attn_compute<DQK>(v, a1, cb_ + TBUFB, qf, mref, negm, l, o, lane, r, h);
        tile_sstore<DQK>(Rb, nb_ + TBUFB, tid);
        __syncthreads();
        a0 = b0; a1 = b1; cur ^= 1;
        if (a0 < 0) break;
    }
}
template <int NCH> DI void load_q(bf16x8* qf, const bf16_t* qrow, int h) {
#pragma unroll
    for (int c = 0; c < NCH; ++c) qf[c] = *(const GAS bf16x8*)(qrow + 16 * c + 8 * h);
}
DI void store_o(bf16_t* dst, const f32x16 (&o)[2], float inv, int h) {
#pragma unroll
    for (int dt = 0; dt < 2; ++dt)
#pragma unroll
        for (int g = 0; g < 4; ++g) {
            u32x2 w; w.x = cvtpk(o[dt][4 * g] * inv, o[dt][4 * g + 1] * inv); w.y = cvtpk(o[dt][4 * g + 2] * inv, o[dt][4 * g + 3] * inv);
            *(u32x2*)(dst + 32 * dt + 8 * g + 4 * h) = w;
        }
}
DI void zero_o(f32x16 (&o)[2]) {
#pragma unroll
    for (int i = 0; i < 16; ++i) { o[0][i] = 0.f; o[1][i] = 0.f; }
}

struct MlaV {
    static constexpr bool EXCL = false;
    const char* kvb; const char* krb;
    int tq, ntile, tstart;
    DI const char* krow(int t, int row) const { return kvb + (size_t)(t * 64 + row) * 256; }
    DI const char* vrow(int t, int row) const { return kvb + (size_t)(t * 64 + row) * 256 + 128; }
    DI const char* k2row(int t, int row) const { return krb + (size_t)(t * 64 + row) * 64; }
    DI int first_tile() const { return 0; }
    DI int next_tile(int t) const { return (t + 1 < ntile) ? t + 1 : -1; }
    DI void range(int t, int& lo, int& hi) const { lo = 0; hi = tq - t * 64; }
};
template <int MODE>
DI void mla_attn_phase(LAS char* lds, const bf16_t* Q, const bf16_t* KV, const bf16_t* KR, bf16_t* AO, int bid, int G) {
    const int tid = OTID(), lane = tid & 63, w = tid >> 6, r = lane & 31, h = lane >> 5;
    int k = 0;
    for (int u = bid; u < 2048; u += G, ++k) {
        const int bh = u & 31, j = u >> 5;
        const int rnd = j >> 3, jj = j & 7;
        const int qb = 63 - (rnd * 8 + ((rnd & 1) ? (7 - jj) : jj));
        const int b = bh >> 4, hd = bh & 15;
        MlaV v; v.kvb = (const char*)(KV + (size_t)(b * 16 + hd) * SEQ * 128); v.krb = (const char*)(KR + (size_t)b * SEQ * 32);
        v.ntile = 4 * qb + 4; v.tq = qb * 256 + w * 32 + r; v.tstart = (int)(((unsigned)(u >> 5) * 5u % 8u) * (unsigned)v.ntile / 8u);
        const size_t grow = (size_t)b * SEQ + v.tq;
        bf16x8 qf[6]; load_q<6>(qf, Q + grow * 1536 + hd * 96, h);
        float m = -INFINITY, l = 0.f; f32x16 o[2]; zero_o(o);
        attn_loop<96, MlaV, MODE>(v, lds, qf, m, l, o);
        const float lt = l + __shfl_xor(l, 32); const float inv = lt > 0.f ? 1.0f / lt : 0.f;
        store_o(AO + grow * 1024 + hd * 64, o, inv, h);
    }
}
struct WinV {
    static constexpr bool EXCL = false;
    const char* kb; const char* vb; int tq, t0, t1;
    DI const char* krow(int t, int row) const { return kb + (size_t)(t * 64 + row) * 128; }
    DI const char* vrow(int t, int row) const { return vb + (size_t)(t * 64 + row) * 128; }
    DI int first_tile() const { return t0; }
    DI int next_tile(int t) const { return (t + 1 <= t1) ? t + 1 : -1; }
    DI void range(int t, int& lo, int& hi) const { lo = tq - 511 - t * 64; hi = tq - t * 64; }
};
DI void win_attn_phase(LAS char* lds, const bf16_t* P, bf16_t* OW, int bid, int G) {
    const int tid = OTID(), lane = tid & 63, w = tid >> 6, r = lane & 31, h = lane >> 5;
    for (int u = bid; u < 1024; u += G) {
        const int cb = u & 255, bg = u >> 8, b = bg >> 1, g = bg & 1;
        WinV v;
        v.kb = (const char*)(PSLOT(P, C_KW + g * 64) + (size_t)b * SEQ * 64); v.vb = (const char*)(PSLOT(P, C_VW + g * 64) + (size_t)b * SEQ * 64);
        v.t0 = cb >= 8 ? cb - 8 : 0; v.t1 = cb; v.tq = cb * 64 + w * 8 + (r >> 2);
        const int hd = g * 4 + (r & 3);
        const size_t grow = (size_t)b * SEQ + v.tq;
        bf16x8 qf[4]; load_q<4>(qf, PSLOT(P, C_QA + hd * 64) + grow * 64, h);
        float m = -INFINITY, l = 0.f; f32x16 o[2]; zero_o(o);
        attn_loop<64>(v, lds, qf, m, l, o);
        const float lt = l + __shfl_xor(l, 32); const float inv = lt > 0.f ? 1.0f / lt : 0.f;
        store_o(OW + grow * 512 + hd * 64, o, inv, h);
    }
}
struct SelV {
    static constexpr bool EXCL = true;
    const char* kb; const char* vb; int tq, cb; unsigned long long u0, u1, u2, u3, m0, m1, m2, m3;
    DI const char* krow(int t, int row) const { return kb + (size_t)(t * 64 + row) * 128; }
    DI const char* vrow(int t, int row) const { return vb + (size_t)(t * 64 + row) * 128; }
    DI unsigned long long uword(int i) const { return i == 0 ? u0 : (i == 1 ? u1 : (i == 2 ? u2 : u3)); }
    DI unsigned long long tword(int i) const { return i == 0 ? m0 : (i == 1 ? m1 : (i == 2 ? m2 : m3)); }
    DI int next_tile(int t) const { for (int j = t + 1; j <= cb; ++j) if ((uword(j >> 6) >> (j & 63)) & 1ull) return j; return -1; }
    DI int first_tile() const { return next_tile(-1); }
    DI bool excluded(int t) const { return !((tword(t >> 6) >> (t & 63)) & 1ull); }
    DI void range(int t, int& lo, int& hi) const { lo = 0; hi = tq - t * 64; }
};
DI void sel_attn_phase(LAS char* lds, const bf16_t* P, const unsigned* SELM, const bf16_t* OC, const bf16_t* OW, bf16_t* AO, int bid, int G) {
    const int tid = OTID(), lane = tid & 63, w = tid >> 6, r = lane & 31, h = lane >> 5;
    LAS unsigned* uni = (LAS unsigned*)(lds + UNI_OFF);
    for (int u = bid; u < 1024; u += G) {
        const int bg = u >> 8, cb = (bg & 1) ? 255 - (u & 255) : (u & 255), b = bg >> 1, g = bg & 1;
        SelV v;
        v.kb = (const char*)(PSLOT(P, C_KS + g * 64) + (size_t)b * SEQ * 64); v.vb = (const char*)(PSLOT(P, C_VS + g * 64) + (size_t)b * SEQ * 64);
        v.cb = cb; v.tq = cb * 64 + w * 8 + (r >> 2);
        const int hl = r & 3, hd = g * 4 + hl;
        const size_t grow = (size_t)b * SEQ + v.tq;
        {
            const u32x4* sp = (const u32x4*)(SELM + ((size_t)bg * SEQ + v.tq) * 8);
            const u32x4 a = sp[0], c = sp[1];
            v.m0 = ((unsigned long long)a.y << 32) | a.x; v.m1 = ((unsigned long long)a.w << 32) | a.z;
            v.m2 = ((unsigned long long)c.y << 32) | c.x; v.m3 = ((unsigned long long)c.w << 32) | c.z;
            __syncthreads();
            if (tid < 8) uni[tid] = 0u;
            __syncthreads();
            atomicOr((unsigned*)(uni + 0), a.x); atomicOr((unsigned*)(uni + 1), a.y); atomicOr((unsigned*)(uni + 2), a.z); atomicOr((unsigned*)(uni + 3), a.w);
            atomicOr((unsigned*)(uni + 4), c.x); atomicOr((unsigned*)(uni + 5), c.y); atomicOr((unsigned*)(uni + 6), c.z); atomicOr((unsigned*)(uni + 7), c.w);
            __syncthreads();
            v.u0 = ((unsigned long long)uni[1] << 32) | uni[0]; v.u1 = ((unsigned long long)uni[3] << 32) | uni[2];
            v.u2 = ((unsigned long long)uni[5] << 32) | uni[4]; v.u3 = ((unsigned long long)uni[7] << 32) | uni[6];
        }
        bf16x8 qf[4]; load_q<4>(qf, PSLOT(P, C_QA + hd * 64) + grow * 64, h);
        float m = -INFINITY, l = 0.f; f32x16 o[2]; zero_o(o);
        attn_loop<64>(v, lds, qf, m, l, o);
        const float lt = l + __shfl_xor(l, 32); const float inv = lt > 0.f ? 1.0f / lt : 0.f;
        const bf16_t* gp = PSLOT(P, C_GT) + grow * 32 + hd * 3;
        const float gc = bf2f(gp[0]), gs = bf2f(gp[1]) * inv, gw = bf2f(gp[2]);
        const bf16_t* ocp = OC + grow * 512 + hd * 64; const bf16_t* owp = OW + grow * 512 + hd * 64; bf16_t* dst = AO + grow * 1024 + hd * 64;
#pragma unroll
        for (int dt = 0; dt < 2; ++dt)
#pragma unroll
            for (int q4 = 0; q4 < 4; ++q4) {
                const int d = 32 * dt + 8 * q4 + 4 * h;
                const u32x2 c2 = *(const u32x2*)(ocp + d), w2 = *(const u32x2*)(owp + d);
                const float r0 = gc * bflo(c2.x) + gs * o[dt][4 * q4] + gw * bflo(w2.x);
                const float r1 = gc * bfhi(c2.x) + gs * o[dt][4 * q4 + 1] + gw * bfhi(w2.x);
                const float r2 = gc * bflo(c2.y) + gs * o[dt][4 * q4 + 2] + gw * bflo(w2.y);
                const float r3 = gc * bfhi(c2.y) + gs * o[dt][4 * q4 + 3] + gw * bfhi(w2.y);
                u32x2 ww; ww.x = cvtpk(r0, r1); ww.y = cvtpk(r2, r3);
                *(u32x2*)(dst + d) = ww;
            }
    }
}

struct CmpV {
    const char* kb; const char* vb; int imax, ntile;
    DI const char* krow(int t, int row) const { return kb + (size_t)(t * 64 + row) * 128; }
    DI const char* vrow(int t, int row) const { return vb + (size_t)(t * 64 + row) * 128; }
    DI int first_tile() const { return 0; }
    DI int next_tile(int t) const { return (t + 1 < ntile) ? t + 1 : -1; }
    DI void range(int t, int& lo, int& hi) const { lo = 0; hi = imax - t * 64; }
};
DI void cmp_attn_phase(LAS char* lds, const bf16_t* P, const bf16_t* KC, const bf16_t* VC, bf16_t* OC, unsigned* SELM, int bid, int G) {
    const int tid = OTID(), lane = tid & 63, w = tid >> 6, r = lane & 31, h = lane >> 5;
    LAS float* imp = (LAS float*)(lds + IMP_OFF);
    for (int u = bid; u < 1024; u += G) {
        const int bg = u >> 8, cb = (bg & 1) ? 255 - (u & 255) : (u & 255), b = bg >> 1, g = bg & 1;
        CmpV v; v.kb = (const char*)(KC + (size_t)bg * 1024 * 64); v.vb = (const char*)(VC + (size_t)bg * 1024 * 64);
        const int cnt = (4 * cb + 3) < 1023 ? (4 * cb + 3) : 1023; v.ntile = (cnt + 63) >> 6;
        const int tq = cb * 64 + w * 8 + (r >> 2); v.imax = (tq - 31) >> 4;
        const int hd = g * 4 + (r & 3);
        const size_t grow = (size_t)b * SEQ + tq;
        bf16x8 qf[4]; load_q<4>(qf, PSLOT(P, C_QA + hd * 64) + grow * 64, h);
        f32x16 zc;
#pragma unroll
        for (int i = 0; i < 16; ++i) zc[i] = 0.f;
        float m = -INFINITY, l = 0.f;
        TileRegs tr;
        __syncthreads();
        tile_gload<64>(tr, v, 0, tid); tile_sstore<64>(tr, lds, tid);
        __syncthreads();
        int cur = 0;
        for (int t = 0; t < v.ntile; ++t) {
            const bool more = t + 1 < v.ntile;
            if (more) tile_gload<64>(tr, v, t + 1, tid);
            LAS char* buf = lds + cur * TBUFB;
            int lo, hi; v.range(t, lo, hi);
            if (__any(hi >= 0)) {
                f32x16 s0, s1; qk_tile<4>(s0, s1, buf, qf, r, h, zc);
                if (!__all(hi >= 63)) mask_tile(s0, s1, lo, hi, h);
                const float mx = tile_max_full(s0, s1); const float mn = fmaxf(m, mx); const float mu = (mn == -INFINITY) ? 0.f : mn;
                float sum = 0.f;
#pragma unroll
                for (int i = 0; i < 16; ++i) sum += fexp2(s0[i] - mu) + fexp2(s1[i] - mu);
                l = l * fexp2(m - mu) + sum; m = mn;
            }
            if (more) tile_sstore<64>(tr, lds + (cur ^ 1) * TBUFB, tid);
            __syncthreads();
            cur ^= 1;
        }
        const float lt = l + __shfl_xor(l, 32); const float inv = lt > 0.f ? 1.0f / lt : 0.f;
        const float mu = (m == -INFINITY) ? 0.f : m;
        f32x16 o[2]; zero_o(o);
        float carry = 0.f;
        tile_gload<64>(tr, v, 0, tid); tile_sstore<64>(tr, lds, tid);
        __syncthreads();
        cur = 0;
        for (int t = 0; t < v.ntile; ++t) {
            const bool more = t + 1 < v.ntile;
            if (more) tile_gload<64>(tr, v, t + 1, tid);
            LAS char* buf = lds + cur * TBUFB;
            int lo, hi; v.range(t, lo, hi);
            if (__any(hi >= 0)) {
                f32x16 s0, s1; qk_tile<4>(s0, s1, buf, qf, r, h, zc);
                if (!__all(hi >= 63)) mask_tile(s0, s1, lo, hi, h);
#pragma unroll
                for (int i = 0; i < 16; ++i) { s0[i] = fexp2(s0[i] - mu) * inv; s1[i] = fexp2(s1[i] - mu) * inv; }
                bf16x8 pf[4]; pack_p(pf, s0, s1);
                pv_tile(o, buf + KBUFB, pf, lane);
                float av[2][4], rc[2][4];
#pragma unroll
                for (int g4 = 0; g4 < 4; ++g4) {
                    av[0][g4] = 2.f * (s0[4 * g4] + s0[4 * g4 + 1] + s0[4 * g4 + 2]) + s0[4 * g4 + 3];
                    av[1][g4] = 2.f * (s1[4 * g4] + s1[4 * g4 + 1] + s1[4 * g4 + 2]) + s1[4 * g4 + 3];
                    rc[0][g4] = __shfl_xor(s0[4 * g4 + 3], 32); rc[1][g4] = __shfl_xor(s1[4 * g4 + 3], 32);
                }
#pragma unroll
                for (int sub = 0; sub < 2; ++sub)
#pragma unroll
                    for (int g4 = 0; g4 < 4; ++g4) {
                        const float prevh0 = (g4 >= 1) ? rc[sub][g4 - 1] : ((sub == 1) ? rc[0][3] : carry);
                        float val = av[sub][g4] + (h ? rc[sub][g4] : prevh0);
                        val += __shfl_xor(val, 1); val += __shfl_xor(val, 2);
                        if ((r & 3) == 0) imp[(w * 8 + (r >> 2)) * 256 + t * 16 + sub * 8 + g4 * 2 + h] = val;
                    }
                carry = rc[1][3];
            }
            if (more) tile_sstore<64>(tr, lds + (cur ^ 1) * TBUFB, tid);
            __syncthreads();
            cur ^= 1;
        }
        store_o(OC + grow * 512 + hd * 64, o, 1.0f, h);
        __syncthreads();
        const int nfree = 16 - (cb == 0 ? 1 : (cb == 1 ? 2 : 3));
        for (int tk = 0; tk < 8; ++tk) {
            const int tl = w * 8 + tk;
            unsigned vb[4]; bool cand[4], sel[4];
#pragma unroll
            for (int s = 0; s < 4; ++s) { const int j = lane + 64 * s;
                cand[s] = (j >= 1) && (j <= cb - 2);
                vb[s] = cand[s] ? __float_as_uint(imp[tl * 256 + j]) : 0u;
                sel[s] = (j == 0) || (j == cb) || (j == cb - 1); }
            unsigned thr = 0u;
            for (int bit = 30; bit >= 0; --bit) {
                const unsigned trial = thr | (1u << bit);
                int cnt = 0;
#pragma unroll
                for (int s = 0; s < 4; ++s) cnt += __popcll(__ballot(cand[s] && vb[s] >= trial));
                thr = (cnt >= nfree) ? trial : thr;
                if (cnt == nfree) break;
            }
            int cgt = 0;
#pragma unroll
            for (int s = 0; s < 4; ++s) cgt += __popcll(__ballot(cand[s] && vb[s] > thr));
            int need = nfree - cgt, pre = 0;
            const unsigned long long ltmask = (1ull << lane) - 1ull;
#pragma unroll
            for (int s = 0; s < 4; ++s) {
                const bool eq = cand[s] && (vb[s] == thr);
                const unsigned long long bm = __ballot(eq);
                const int rank = pre + __popcll(bm & ltmask);
                sel[s] = sel[s] || (cand[s] && vb[s] > thr) || (eq && rank < need);
                pre += __popcll(bm);
            }
            unsigned long long bmo[4];
#pragma unroll
            for (int s = 0; s < 4; ++s) bmo[s] = __ballot(sel[s]);
            if (lane == 0) {
                u32x4* dp = (u32x4*)(SELM + ((size_t)bg * SEQ + cb * 64 + tl) * 8);
                u32x4 a, c; a.x = (unsigned)bmo[0]; a.y = (unsigned)(bmo[0] >> 32); a.z = (unsigned)bmo[1]; a.w = (unsigned)(bmo[1] >> 32);
                c.x = (unsigned)bmo[2]; c.y = (unsigned)(bmo[2] >> 32); c.z = (unsigned)bmo[3]; c.w = (unsigned)(bmo[3] >> 32);
                dp[0] = a; dp[1] = c;
            }
        }
    }
}
struct DilV {
    static constexpr bool EXCL = false;
    const char* kb; const char* vb; size_t rstride; int pq, t0, t1;
    DI const char* krow(int t, int row) const { return kb + (size_t)(t * 64 + row) * rstride; }
    DI const char* vrow(int t, int row) const { return vb + (size_t)(t * 64 + row) * rstride; }
    DI int first_tile() const { return t0; }
    DI int next_tile(int t) const { return (t + 1 <= t1) ? t + 1 : -1; }
    DI void range(int t, int& lo, int& hi) const { lo = pq - 128 - t * 64; hi = pq - t * 64; }
};
DI void dil_attn_phase(LAS char* lds, const bf16_t* P, bf16_t* DO, float* LSE, bf16_t* AO, int br, int bid, int G) {
    const int tid = OTID(), lane = tid & 63, w = tid >> 6, r = lane & 31, h = lane >> 5;
    const int sh = 2 * br, dil = 1 << sh;
    for (int u = bid; u < 1024; u += G) {
        const int x = u & 63, bh = u >> 6, b = bh >> 3, hd = bh & 7;
        const int res = x & (dil - 1), blk = x >> sh;
        const int P0 = blk * 256;
        DilV v;
        v.kb = (const char*)(PSLOT(P, C_KB + hd * 64) + ((size_t)b * SEQ + res) * 64); v.vb = (const char*)(PSLOT(P, C_VB + hd * 64) + ((size_t)b * SEQ + res) * 64);
        v.rstride = (size_t)128 * dil;
        v.pq = P0 + w * 32 + r; v.t0 = blk * 4 >= 2 ? blk * 4 - 2 : 0; v.t1 = blk * 4 + 3;
        const int tq = v.pq * dil + res;
        const size_t grow = (size_t)b * SEQ + tq;
        bf16x8 qf[4]; load_q<4>(qf, PSLOT(P, C_QB + hd * 64) + grow * 64, h);
        float m = -INFINITY, l = 0.f; f32x16 o[2]; zero_o(o);
        attn_loop<64>(v, lds, qf, m, l, o);
        const float lt = l + __shfl_xor(l, 32); const float inv = 1.0f / lt;
        const float lse = (m + __builtin_amdgcn_logf(lt)) * LN2;
        if (br < 2) {
            store_o(DO + (size_t)br * M * 512 + grow * 512 + hd * 64, o, inv, h);
            if (h == 0) LSE[(size_t)br * M * 8 + grow * 8 + hd] = lse;
        } else {
            const float l0 = LSE[grow * 8 + hd], l1 = LSE[(size_t)M * 8 + grow * 8 + hd];
            const float mxl = fmaxf(lse, fmaxf(l0, l1));
            const float e0 = __expf(l0 - mxl), e1 = __expf(l1 - mxl), e2 = __expf(lse - mxl);
            const float is = 1.0f / (e0 + e1 + e2);
            const float w0 = e0 * is, w1 = e1 * is, w2 = e2 * is * inv;
            const bf16_t* p0 = DO + grow * 512 + hd * 64; const bf16_t* p1 = DO + (size_t)M * 512 + grow * 512 + hd * 64;
            bf16_t* dst = AO + grow * 1024 + 512 + hd * 64;
#pragma unroll
            for (int dt = 0; dt < 2; ++dt)
#pragma unroll
                for (int q4 = 0; q4 < 4; ++q4) {
                    const int d = 32 * dt + 8 * q4 + 4 * h;
                    const u32x2 a2 = *(const u32x2*)(p0 + d), b2 = *(const u32x2*)(p1 + d);
                    const float r0 = w0 * bflo(a2.x) + w1 * bflo(b2.x) + w2 * o[dt][4 * q4];
                    const float r1 = w0 * bfhi(a2.x) + w1 * bfhi(b2.x) + w2 * o[dt][4 * q4 + 1];
                    const float r2 = w0 * bflo(a2.y) + w1 * bflo(b2.y) + w2 * o[dt][4 * q4 + 2];
                    const float r3 = w0 * bfhi(a2.y) + w1 * bfhi(b2.y) + w2 * o[dt][4 * q4 + 3];
                    u32x2 ww; ww.x = cvtpk(r0, r1); ww.y = cvtpk(r2, r3);
                    *(u32x2*)(dst + d) = ww;
                }
        }
    }
}

DI float wave_sum(float v) {
#pragma unroll
    for (int o = 1; o < 64; o <<= 1) v += __shfl_xor(v, o);
    return v;
}
template <int MODE> DI int rowmap(int n) {
    if (MODE == 1) return (n >> 7) * 256 + (n & 127);
    if (MODE == 2) return (n >> 7) * 256 + 128 + (n & 127);
    if (MODE == 3) return n < 1280 ? n : (n < 1304 ? (C_GT + n - 1280) : (n - 24));
    if (MODE == 4) return n + 128;
    return n;
}
template <int MODE>
DI void tr_item(const float* W, int K, int N, bf16_t* WT, const float* gamma, LAS float* scr, int item, int lane) {
    const int nblk = (N + 63) / 64, kb = item / nblk, nb = item % nblk, k0 = 64 * kb, n0 = 64 * nb;
    const int ncol = n0 + 4 * (lane & 15), kr = lane >> 4;
    const bool okc = ncol < N;
#pragma unroll
    for (int j = 0; j < 16; ++j) { const int kk = kr + 4 * j;
        f32x4 x = okc ? *(const GAS f32x4*)(W + (size_t)(k0 + kk) * N + ncol) : (f32x4){0.f, 0.f, 0.f, 0.f};
        if (gamma) x = x * gamma[k0 + kk];
        *(LAS f32x4*)(scr + kk * 68 + 4 * (lane & 15)) = x; }
    asm volatile("s_waitcnt lgkmcnt(0)" ::: "memory");
    const int c = lane & 7;
#pragma unroll
    for (int j = 0; j < 8; ++j) { const int n = (lane >> 3) + 8 * j; const LAS float* s = scr + (8 * c) * 68 + n;
        u32x4 o; o.x = cvtpk(s[0 * 68], s[1 * 68]); o.y = cvtpk(s[2 * 68], s[3 * 68]); o.z = cvtpk(s[4 * 68], s[5 * 68]); o.w = cvtpk(s[6 * 68], s[7 * 68]);
        if (n0 + n < N) *(u32x4*)(WT + (size_t)rowmap<MODE>(n0 + n) * K + k0 + 8 * c) = o; }
    asm volatile("s_waitcnt lgkmcnt(0)" ::: "memory");
}
#define TR_JOB(MODE, Wp, Kk, Nn, WTp, gam) do { const int nit_ = ((Kk) / 64) * (((Nn) + 63) / 64); \
    int first_ = gwi - (tr_base % NGW); if (first_ < 0) first_ += NGW; tr_base += nit_; \
    for (int it_ = first_; it_ < nit_; it_ += NGW) tr_item<MODE>((Wp), (Kk), (Nn), (WTp), (gam), scr, it_, lane); } while (0)

#define XB_TMO      128
#define XB_XCNT(j)  (256  + 64 * (j))
#define XB_XSUB(j)  (1280 + 64 * (j))
#define XB_XGEN(j)  (2304 + 64 * (j))
#define XB_TOP      3328
#define XB_TOPGEN   3392
#define XCD_BAR_WORDS 3456
#define XB_SPIN_CAP (1u << 22)
DI unsigned xb_ld(unsigned* p)              { return __hip_atomic_load(p, __ATOMIC_RELAXED, __HIP_MEMORY_SCOPE_AGENT); }
DI unsigned xb_add(unsigned* p, unsigned v) { return __hip_atomic_fetch_add(p, v, __ATOMIC_RELAXED, __HIP_MEMORY_SCOPE_AGENT); }
DI unsigned xb_xcc_id() { return (unsigned)__builtin_amdgcn_s_getreg((3 << 11) | 20) & 0xFu; }
#define XB_SPIN(cond, bar) do { unsigned _sp = 0; while (cond) { __builtin_amdgcn_s_sleep(1); \
    if ((++_sp & 255u) == 0u) { if (xb_ld(&(bar)[XB_TMO])) break; if (_sp > XB_SPIN_CAP) { atomicAdd(&(bar)[XB_TMO], 1u); break; } } } } while (0)
struct XcdBarrier { unsigned* bar; unsigned x; volatile LAS unsigned* st; };
DI XcdBarrier xcd_barrier_post(unsigned* bar, volatile LAS unsigned* st) {
    XcdBarrier b; b.bar = bar; b.x = xb_xcc_id(); b.st = st;
    if (threadIdx.x == 0) (void)xb_add(&bar[XB_XCNT(b.x)], 1u);
    return b;
}
DI void xcd_barrier_complete(unsigned* bar, unsigned x, unsigned& nloc, unsigned& nx) {
    const unsigned G = gridDim.x * gridDim.y * gridDim.z;
    unsigned sum, cnt, mine, sp = 0u;
    for (;;) {
        sum = 0u; cnt = 0u; mine = 0u;
#pragma unroll
        for (unsigned j = 0; j < 16; ++j) { const unsigned c = xb_ld(&bar[XB_XCNT(j)]); sum += c; cnt += (c > 0u) ? 1u : 0u; mine = (j == x) ? c : mine; }
        if (sum == G) break;
        __builtin_amdgcn_s_sleep(1);
        if ((++sp & 255u) == 0u) { if (xb_ld(&bar[XB_TMO])) break; if (sp > XB_SPIN_CAP) { atomicAdd(&bar[XB_TMO], 1u); break; } }
    }
    nloc = mine > 0u ? mine : 1u; nx = cnt > 0u ? cnt : 1u;
}
DI void xcd_barrier(const XcdBarrier& b) {
    asm volatile("s_waitcnt vmcnt(0)" ::: "memory");
    __syncthreads();
    if (threadIdx.x == 0) {
        unsigned* bar = b.bar;
        __builtin_amdgcn_s_waitcnt(0);
        unsigned nloc = b.st[0], nx = b.st[1];
        if (nloc == 0u) { xcd_barrier_complete(bar, b.x, nloc, nx); b.st[0] = nloc; b.st[1] = nx; }
        const unsigned old = xb_add(&bar[XB_XSUB(b.x)], 1u);
        const unsigned gen = old / nloc;
        if (old + 1u == (gen + 1u) * nloc) {
            __builtin_amdgcn_fence(__ATOMIC_RELEASE, "agent");
            asm volatile("s_waitcnt vmcnt(0)" ::: "memory");
            const unsigned og = xb_add(&bar[XB_TOP], 1u);
            const unsigned tg = og / nx;
            if (og + 1u == (tg + 1u) * nx) xb_add(&bar[XB_TOPGEN], 1u);
            else XB_SPIN(xb_ld(&bar[XB_TOPGEN]) == tg, bar);
            __builtin_amdgcn_fence(__ATOMIC_ACQUIRE, "agent");
            xb_add(&bar[XB_XGEN(b.x)], 1u);
            asm volatile("s_waitcnt vmcnt(0)" ::: "memory");
        } else {
            XB_SPIN(xb_ld(&bar[XB_XGEN(b.x)]) == gen, bar);
            __builtin_amdgcn_fence(__ATOMIC_ACQUIRE, "agent");
            asm volatile("s_waitcnt vmcnt(0)" ::: "memory");
        }
    }
    __syncthreads();
}

struct Args { const float* in[25]; float* out; unsigned char* ws; };
constexpr int LDS_BYTES = 147456;
#ifndef PHM
#define PHM 0xFFFFFF
#endif
#define PHON(b) ((PHM >> (b)) & 1)
#ifndef REP_MLA
#define REP_MLA 1
#endif
#ifndef REP_EVEN
#define REP_EVEN 1
#endif
#ifndef PROBE_MODE
#define PROBE_MODE 3
#endif
#ifndef SEL_PROBE_T
#define SEL_PROBE_T 1
#endif
#ifndef REP_EIN
#define REP_EIN 1
#endif
#ifndef REP_UQKV
#define REP_UQKV 1
#endif
#ifndef REP_SEL
#define REP_SEL 1
#endif
#ifndef REP_CMP
#define REP_CMP 1
#endif
#ifndef REP_DIL
#define REP_DIL 1
#endif
#ifndef REP_WIN
#define REP_WIN 1
#endif
#ifndef REP_PRO
#define REP_PRO 1
#endif
#ifndef REP_SYNC
#define REP_SYNC 0
#endif
#ifndef REP_FFNUP
#define REP_FFNUP 1
#endif

__global__ void __launch_bounds__(512, 2) mega_fwd(Args a) {
    extern __shared__ __attribute__((aligned(16))) unsigned char lds_raw[];
    LAS unsigned char* lds = (LAS unsigned char*)lds_raw;
    cg::grid_group grid = cg::this_grid();
    const int tid = threadIdx.x, lane = tid & 63, wave = __builtin_amdgcn_readfirstlane(tid >> 6);
    const int G = gridDim.x, bid = blockIdx.x;
    volatile LAS unsigned* bst = (volatile LAS unsigned*)(lds + LDS_BYTES - 64);
    if (tid < 2) bst[tid] = 0u;
    __syncthreads();
    const XcdBarrier xbar = xcd_barrier_post((unsigned*)a.ws + 1024, bst);
#define GSYNC() xcd_barrier(xbar)
    float* X = a.out;
#define WSB ({ unsigned char* p_ = a.ws; asm volatile("" : "+s"(p_)); p_; })
#define WGU ((bf16_t*)(WSB + WS_WGU))
#define WD ((bf16_t*)(WSB + WS_WD))
#define WEI ((bf16_t*)(WSB + WS_WEI))
#define WEO ((bf16_t*)(WSB + WS_WEO))
#define WC1 ((bf16_t*)(WSB + WS_WC1))
#define WMI ((bf16_t*)(WSB + WS_WMI))
#define WUQ ((bf16_t*)(WSB + WS_WUQ))
#define WUKV ((bf16_t*)(WSB + WS_WUKV))
#define WMO ((bf16_t*)(WSB + WS_WMO))
#define CSP ((float*)(WSB + WS_CSP))
#define CSM ((float*)(WSB + WS_CSM))
#define RS ((float*)(WSB + WS_RS))
#define XB ((bf16_t*)(WSB + WS_XB))
#define AO ((bf16_t*)(WSB + WS_AO))
#define BIG ((bf16_t*)(WSB + WS_BIG))
#define MID (WSB + WS_MID)

#pragma unroll 1
    for (int rep = 0; rep < REP_PRO; ++rep)
    if (PHON(0)) {
        LAS float* scr = (LAS float*)(lds + wave * 17408);
        const int gw = bid * 8 + wave, NGW = G * 8;
        const int gwi = wave * G + bid; int tr_base = 0;
        for (int f = 0; f < 4; ++f) {
            const int l = f >> 1, sec = f & 1;
            const float* gam = a.in[sec ? 5 : 1] + (size_t)l * 1024;
            const float* wg = a.in[sec ? 6 : 2] + (size_t)l * 1024 * 2816;
            const float* wu = a.in[sec ? 7 : 3] + (size_t)l * 1024 * 2816;
            const float* wd = a.in[sec ? 8 : 4] + (size_t)l * 1024 * 2816;
            bf16_t* wgu = WGU + (size_t)f * 5632 * 1024; bf16_t* wdt = WD + (size_t)f * 1024 * 2816;
            TR_JOB(1, wg, 1024, 2816, wgu, gam);
            TR_JOB(2, wu, 1024, 2816, wgu, gam);
            TR_JOB(0, wd, 2816, 1024, wdt, (const float*)nullptr);
        }
        TR_JOB(3, a.in[10], 1024, 2840, WEI, a.in[9]);
        TR_JOB(0, a.in[11], 1024, 1024, WEO, (const float*)nullptr);
        TR_JOB(0, a.in[14], 2048, 128, WC1, (const float*)nullptr);
        TR_JOB(4, a.in[16], 2048, 128, WC1, (const float*)nullptr);
        TR_JOB(0, a.in[18], 1024, 416, WMI, a.in[9] + 1024);
        TR_JOB(0, a.in[21], 256, 1536, WUQ, a.in[19]);
        TR_JOB(0, a.in[22], 128, 2048, WUKV, a.in[20]);
        TR_JOB(0, a.in[23], 1024, 1024, WMO, (const float*)nullptr);
        const int gt = bid * 512 + tid, NGT = G * 512;
        for (int i = gt; i < 232 * 128; i += NGT) *(u32x4*)(WEI + (size_t)2840 * 1024 + (size_t)i * 8) = (u32x4){0u, 0u, 0u, 0u};
        for (int i = gt; i < 96 * 128; i += NGT) *(u32x4*)(WMI + (size_t)416 * 1024 + (size_t)i * 8) = (u32x4){0u, 0u, 0u, 0u};
        const float l2t = 18.931568569324174f;
        for (int i = gt; i < SEQ * 8; i += NGT) { const int t = i >> 3, k = i & 7;
            const float inv = exp2f(-(float)k * 0.125f * l2t); const float ang = (float)t * inv;
            const double rev = (double)ang * 0.15915494309189535; const float fr = (float)(rev - floor(rev));
            CSP[t * 16 + k] = __builtin_amdgcn_cosf(fr); CSP[t * 16 + 8 + k] = __builtin_amdgcn_sinf(fr); }
        for (int i = gt; i < SEQ * 16; i += NGT) { const int t = i >> 4, k = i & 15;
            const float inv = exp2f(-(float)k * 0.0625f * l2t); const float ang = (float)t * inv;
            const double rev = (double)ang * 0.15915494309189535; const float fr = (float)(rev - floor(rev));
            CSM[t * 32 + k] = __builtin_amdgcn_cosf(fr); CSM[t * 32 + 16 + k] = __builtin_amdgcn_sinf(fr); }
        for (int i = gt; i < 8 * M; i += NGT) RS[M + i] = 0.f;
        const float* xin = a.in[0];
        for (int m = gw; m < M; m += NGW) {
            const f32x4* xr = (const f32x4*)(xin + (size_t)m * DM) + lane; float s = 0.f; f32x4 v[4];
#pragma unroll
            for (int j = 0; j < 4; ++j) { v[j] = xr[64 * j]; s += (v[j][0] * v[j][0] + v[j][1] * v[j][1]) + (v[j][2] * v[j][2] + v[j][3] * v[j][3]); }
            s = wave_sum(s);
            u32x2* o8 = (u32x2*)(XB + (size_t)m * DM) + lane;
#pragma unroll
            for (int j = 0; j < 4; ++j) { u32x2 w; w.x = cvtpk(v[j][0], v[j][1]); w.y = cvtpk(v[j][2], v[j][3]); o8[64 * j] = w; }
            if (lane == 0) RS[m] = s;
        }
    }
    grid.sync();

#pragma unroll 1
    for (int layer = 0; layer < 2; ++layer) {
#pragma unroll 1
        for (int half = 0; half < 2; ++half) {
            if (half == 1) {
                if (layer == 0) {
                    bf16_t* PROJ = BIG;
                    bf16_t* OC = (bf16_t*)(MID + MID_OC); bf16_t* ACMP = OC; bf16_t* OW = (bf16_t*)(MID + MID_OW);
                    float* LSE = (float*)(MID + MID_LSE); unsigned* SELM = (unsigned*)(MID + MID_SELM);
                    bf16_t* HID = (bf16_t*)(MID + MID_HID); bf16_t* KC = (bf16_t*)(MID + MID_KC); bf16_t* VC = (bf16_t*)(MID + MID_VC);
                    bf16_t* DO = XB;
                    if (PHON(1)) { pg8::Gemm g{XB, WEI, M, PROJ_W, 1024, 1024}; pg8::StaticOrder S; S.init(M, PROJ_W, G, bid);
                      EpiEvenIn E{PROJ, RS + 1 * M, CSP}; pg8::gemm_phase<EpiEvenIn, true>(lds, g, S, E); }
                    GSYNC();
#pragma unroll 1
                    for (int rep = 0; rep < REP_EVEN; ++rep) {
#pragma unroll 1
                    for (int ph = 0; ph < 3; ++ph) {
                        if (ph == 0 && !PHON(2)) {} else if (ph == 0) {
                            const int gt = bid * 512 + OTID(), NGT = G * 512;
                            for (int c = gt; c < 8192 * 256; c += NGT) {
                                const int row = c >> 8, ch = c & 255, kind = row >> 12, bg = (row >> 10) & 3, i = row & 1023, b = bg >> 1, g2 = bg & 1;
                                const int lpos = ch >> 3, d0 = (ch & 7) * 8;
                                u32x4 o = (u32x4){0u, 0u, 0u, 0u};
                                if (i < 1023) {
                                    const u32x4 s = *(const u32x4*)(PSLOT(PROJ, (kind ? C_VC : C_KC) + g2 * 64) + ((size_t)b * SEQ + 16 * i + lpos) * 64 + d0);
                                    const float* pe = a.in[kind ? 13 : 12] + lpos * 64 + d0;
                                    const f32x4 p0 = *(const f32x4*)pe, p1 = *(const f32x4*)(pe + 4);
                                    o.x = cvtpk(bflo(s.x) + p0[0], bfhi(s.x) + p0[1]); o.y = cvtpk(bflo(s.y) + p0[2], bfhi(s.y) + p0[3]);
                                    o.z = cvtpk(bflo(s.z) + p1[0], bfhi(s.z) + p1[1]); o.w = cvtpk(bflo(s.w) + p1[2], bfhi(s.w) + p1[3]);
                                }
                                *(u32x4*)(ACMP + (size_t)row * 2048 + ch * 8) = o;
                            }
                        } else if (ph == 1) {
                            if (PHON(3)) { pg8::Gemm g{ACMP, WC1, 8192, 256, 2048, 2048}; pg8::StaticOrder S; S.init(8192, 256, G, bid);
                              EpiCmp1 E{HID}; pg8::gemm_phase<EpiCmp1, false>(lds, g, S, E); }
#pragma unroll 1
                            for (int rp = 0; rp < REP_WIN; ++rp)
                            if (PHON(4)) win_attn_phase((LAS char*)lds, PROJ, OW, (G > 64) ? (bid < 32 ? 1024 : bid - 32) : bid, (G > 64) ? G - 32 : G);
                        } else {
                            const int gt = bid * 512 + OTID(), NGT = G * 512;
                            for (int c = gt; c < 8192 * 8; c += NGT) {
                                const int row = c >> 3, d0 = (c & 7) * 8, kind = row >> 12;
                                const float* w2 = a.in[kind ? 17 : 15] + d0;
                                const bf16_t* hr = HID + (size_t)row * 128;
                                float acc8[8] = {0.f, 0.f, 0.f, 0.f, 0.f, 0.f, 0.f, 0.f};
                                for (int j = 0; j < 128; j += 2) {
                                    const unsigned hv = *(const unsigned*)(hr + j);
                                    const float h0 = bflo(hv), h1 = bfhi(hv);
                                    const f32x4 wa = *(const f32x4*)(w2 + (size_t)j * 64), wb = *(const f32x4*)(w2 + (size_t)j * 64 + 4);
                                    const f32x4 wc2 = *(const f32x4*)(w2 + (size_t)(j + 1) * 64), wd2 = *(const f32x4*)(w2 + (size_t)(j + 1) * 64 + 4);
#pragma unroll
                                    for (int e = 0; e < 4; ++e) { acc8[e] += h0 * wa[e] + h1 * wc2[e]; acc8[4 + e] += h0 * wb[e] + h1 * wd2[e]; }
                                }
                                u32x4 o; o.x = cvtpk(acc8[0], acc8[1]); o.y = cvtpk(acc8[2], acc8[3]); o.z = cvtpk(acc8[4], acc8[5]); o.w = cvtpk(acc8[6], acc8[7]);
                                *(u32x4*)((kind ? VC : KC) + (size_t)(row & 4095) * 64 + d0) = o;
                            }
                        }
#pragma unroll 1
                        for (int rp = 0; rp < REP_DIL; ++rp)
                        if (PHON(5)) dil_attn_phase((LAS char*)lds, PROJ, DO, LSE, AO, ph, (ph == 1 && G > 64) ? (bid < 32 ? 1024 : bid - 32) : bid, (ph == 1 && G > 64) ? G - 32 : G);
                        GSYNC();
                    }
#pragma unroll 1
                    for (int rp = 0; rp < REP_CMP; ++rp)
                    if (PHON(6)) cmp_attn_phase((LAS char*)lds, PROJ, KC, VC, OC, SELM, bid, G);
                    GSYNC();
#pragma unroll 1
                    for (int rp = 0; rp < REP_SEL; ++rp)
                    if (PHON(7)) sel_attn_phase((LAS char*)lds, PROJ, SELM, OC, OW, AO, bid, G);
                    GSYNC();
                    }
                } else {
                    bf16_t* Q = BIG; bf16_t* KV = BIG + (size_t)M * 1536; bf16_t* C1 = (bf16_t*)MID; bf16_t* KR = (bf16_t*)(MID + 32 * MiB);
                    if (PHON(8)) { pg8::Gemm g{XB, WMI, M, 512, 1024, 1024}; pg8::StaticOrder S; S.init(M, 512, G, bid);
                      EpiMlaIn E{C1, KR, RS + 4 * M, RS + 7 * M, RS + 8 * M, CSM}; pg8::gemm_phase<EpiMlaIn, true>(lds, g, S, E); }
                    GSYNC();
                    if (PHON(9)) { pg8::Gemm g{C1, WUQ, M, 1536, 256, 512}; pg8::StaticOrder S; S.init(M, 1536, G, bid);
                      EpiMlaQ E{Q, RS + 7 * M, CSM}; pg8::gemm_phase<EpiMlaQ, true>(lds, g, S, E); }
                    if (PHON(10)) { pg8::Gemm g{C1 + 256, WUKV, M, 2048, 128, 512}; pg8::StaticOrder S; S.init(M, 2048, G, bid);
                      EpiMlaKV E{KV, RS + 8 * M}; pg8::gemm_phase<EpiMlaKV, true>(lds, g, S, E); }
                    GSYNC();
#pragma unroll 1
                    for (int rep = 0; rep < REP_MLA; ++rep)
                    if (PHON(11)) { if (rep + 1 < REP_MLA) mla_attn_phase<PROBE_MODE>((LAS char*)lds, Q, KV, KR, AO, bid, G); else mla_attn_phase<3>((LAS char*)lds, Q, KV, KR, AO, bid, G); }
                    GSYNC();
                }
                if (PHON(12)) { pg8::Gemm g{AO, layer == 0 ? WEO : WMO, M, 1024, 1024, 1024}; pg8::StaticOrder S; S.init(M, 1024, G, bid);
                  EpiResid E{X, X, XB, RS + (size_t)(layer * 3 + 2) * M, 1.0f}; pg8::gemm_phase<EpiResid, true>(lds, g, S, E); }
                GSYNC();
            }
            const int f = layer * 2 + half;
            const int rs_in = layer * 3 + half * 2, rs_out = rs_in + 1;
#pragma unroll 1
            for (int rep = 0; rep < REP_FFNUP; ++rep)
            if (PHON(13)) { pg8::Gemm g{XB, WGU + (size_t)f * 5632 * 1024, M, 5632, 1024, 1024}; pg8::StaticOrder S; S.init(M, 5632, G, bid);
              EpiSwiglu E{BIG, RS + (size_t)rs_in * M}; pg8::gemm_phase<EpiSwiglu, true>(lds, g, S, E); }
            GSYNC();
            if (PHON(14)) { pg8::Gemm g{BIG, WD + (size_t)f * 1024 * 2816, M, 1024, 2816, 2816}; pg8::StaticOrder S; S.init(M, 1024, G, bid);
              EpiResid E{(layer == 0 && half == 0) ? a.in[0] : X, X, (layer == 1 && half == 1) ? (bf16_t*)nullptr : XB, RS + (size_t)rs_out * M, 0.5f}; pg8::gemm_phase<EpiResid, true>(lds, g, S, E); }
            GSYNC();
        }
    }
#pragma unroll 1
    for (int rep = 0; rep < REP_SYNC; ++rep) GSYNC();
    {
        const int lane = OTID() & 63; const int gw = bid * 8 + wave, NGW = G * 8;
        const float* gf = a.in[24]; const float* rs = RS + 6 * M;
        for (int m = gw; m < M; m += NGW) {
            const float r = __builtin_amdgcn_rsqf(rs[m] * (1.0f / 1024.0f) + EPS);
            f32x4* xr = (f32x4*)(X + (size_t)m * DM) + lane; const f32x4* gr = (const f32x4*)gf + lane;
#pragma unroll
            for (int j = 0; j < 4; ++j) { const f32x4 v = xr[64 * j]; const f32x4 gg = gr[64 * j]; xr[64 * j] = v * r * gg; }
        }
    }
}

extern "C" void kernel_launch(void* const* d_in, const int* in_sizes, int n_in, void* d_out, int out_size, void* d_ws, size_t ws_size, hipStream_t stream) {
    static int grid = 0;
    if (grid == 0) {
        if (n_in != 25 || out_size != M * DM || ws_size < WS_END) { fprintf(stderr, "kernel_launch: unexpected sizes n_in %d out %d ws %zu (need %zu)\n", n_in, out_size, ws_size, (size_t)WS_END); grid = -1; return; }
        int dev = 0, cus = 0, per_cu = 0;
        hipGetDevice(&dev); hipDeviceGetAttribute(&cus, hipDeviceAttributeMultiprocessorCount, dev);
        if (hipFuncSetAttribute((const void*)mega_fwd, hipFuncAttributeMaxDynamicSharedMemorySize, LDS_BYTES) != hipSuccess) { fprintf(stderr, "kernel_launch: hipFuncSetAttribute failed\n"); grid = -1; return; }
        hipOccupancyMaxActiveBlocksPerMultiprocessor(&per_cu, (const void*)mega_fwd, 512, LDS_BYTES);
        if (per_cu < 1) { fprintf(stderr, "kernel_launch: occupancy query says %d blocks per CU\n", per_cu); per_cu = 1; }
        (void)hipGetLastError();
        grid = cus;
    }
    if (grid < 0) return;
    if (hipMemsetAsync(d_ws, 0, 65536, stream) != hipSuccess) { fprintf(stderr, "kernel_launch: memset of the barrier words failed\n"); return; }
    Args a{};
    for (int i = 0; i < 25; ++i) a.in[i] = (const float*)d_in[i];
    a.out = (float*)d_out; a.ws = (unsigned char*)d_ws;
    void* args[] = {&a};
    hipError_t e = hipLaunchCooperativeKernel((const void*)mega_fwd, dim3(grid), dim3(512), args, LDS_BYTES, stream);
    if (e != hipSuccess) fprintf(stderr, "cooperative launch failed: %s (grid %d)\n", hipGetErrorString(e), grid);
}
```
